# Optimizing an MI355X kernel written in HIP

```python
import jax, jax.numpy as jnp
from jax import lax
import numpy as np

D_MODEL = 1024
BATCH = 8
SEQ = 2048
DEPTH = 1

HEAD_DIM = 64
N_HEADS_A = 8
N_KV_A = 2
WINDOW_A = 128
N_HEADS_B = 8
DILATED_BRANCHES = ((128, 1), (512, 4), (2048, 16))
BLOCK = 128
ROT_DIM = HEAD_DIM // 4
ROPE_THETA = 500000.0
MIX_A = N_HEADS_A * HEAD_DIM
KV_A = N_KV_A * HEAD_DIM
MIX_B = N_HEADS_B * HEAD_DIM
MIX_WIDTH = MIX_A + MIX_B
IN_WIDTH = MIX_A + 2 * KV_A + 3 * MIX_B
N_EXPERTS = 256
TOP_K = 8
N_GROUPS = 8
TOPK_GROUPS = 4
EXPERT_DIM = 256
SHARED_DIM = 256
ROUTED_SCALE = 2.5
EXPERT_BLOCK = 128
EPS = 1e-6

kernel_name = "hybrid_swa_sink_dilated_moe_adaln"

F32 = jnp.float32


def rms_norm(t, g):
    tf = t.astype(F32)
    return tf * lax.rsqrt(jnp.mean(tf * tf, axis=-1, keepdims=True) + EPS) * g.astype(F32)


def rope_tables(positions):
    inv = ROPE_THETA ** (-jnp.arange(0, ROT_DIM, 2, dtype=F32) / ROT_DIM)
    ang = positions.astype(F32)[..., None] * inv
    return jnp.cos(ang)[:, :, None, :], jnp.sin(ang)[:, :, None, :]


def partial_rotary(t, cos, sin):
    half = ROT_DIM // 2
    t1, t2, rest = t[..., :half], t[..., half:ROT_DIM], t[..., ROT_DIM:]
    return jnp.concatenate([t1 * cos - t2 * sin, t2 * cos + t1 * sin, rest], axis=-1)


def banded_attention(q, k, v, max_dist, sinks=None):
    n, L, hk, g, hd = q.shape
    nb = L // BLOCK
    qb = q.reshape(n, nb, BLOCK, hk, g, hd).astype(F32)

    def with_prev(t):
        tb = t.reshape(n, nb, BLOCK, hk, hd).astype(F32)
        prev = jnp.pad(tb, ((0, 0), (1, 0), (0, 0), (0, 0), (0, 0)))[:, :-1]
        return jnp.concatenate([prev, tb], axis=2)

    kk, vv = with_prev(k), with_prev(v)
    s = jnp.einsum('nbqhgd,nbkhd->nbhgqk', qb, kk) * (hd ** -0.5)
    qpos = jnp.arange(BLOCK)[:, None] + BLOCK
    kpos = jnp.arange(2 * BLOCK)[None, :]
    dist = qpos - kpos
    band = (dist >= 0) & (dist <= max_dist)
    has_prev = (jnp.arange(nb)[:, None, None] > 0) | (kpos[None] >= BLOCK)
    mask = band[None] & has_prev
    s = jnp.where(mask[None, :, None, None], s, -jnp.inf)
    if sinks is None:
        lse = jax.nn.logsumexp(s, axis=-1)
    else:
        sink_col = jnp.broadcast_to(sinks.astype(F32)[None, None, :, :, None, None],
                                    s.shape[:-1] + (1,))
        lse = jax.nn.logsumexp(jnp.concatenate([s, sink_col], axis=-1), axis=-1)
    p = jnp.exp(s - lse[..., None])
    o = jnp.einsum('nbhgqk,nbkhd->nbqhgd', p, vv).reshape(n, L, hk, g, hd)
    lse = lse.transpose(0, 1, 4, 2, 3).reshape(n, L, hk, g)
    return o, lse


def dilated_attention(q, k, v):
    B, S, H, hd = q.shape
    outs, lses = [], []
    for window, dil in DILATED_BRANCHES:
        L = S // dil
        Lp = -(-L // BLOCK) * BLOCK

        def to_sub(t):
            t = t.reshape(B, L, dil, H, hd).transpose(0, 2, 1, 3, 4).reshape(B * dil, L, H, hd)
            return jnp.pad(t, ((0, 0), (0, Lp - L), (0, 0), (0, 0)))

        o, lse = banded_attention(to_sub(q)[:, :, :, None], to_sub(k), to_sub(v), window // dil)
        outs.append(o[:, :L, :, 0].reshape(B, dil, L, H, hd).transpose(0, 2, 1, 3, 4).reshape(B, S, H, hd))
        lses.append(lse[:, :L, :, 0].reshape(B, dil, L, H).transpose(0, 2, 1, 3).reshape(B, S, H))
    w = jax.nn.softmax(jnp.stack(lses), axis=0)
    return jnp.einsum('rbsh,rbshd->bshd', w, jnp.stack(outs))


def hybrid_mixer(h, cos, sin, w_in, g_q_a, g_k_a, sinks_a, g_q_b, g_k_b, g_out_a, g_out_b, w_out):
    B, S, _ = h.shape
    proj = h @ w_in
    cuts = [int(i) for i in np.cumsum([MIX_A, KV_A, KV_A, MIX_B, MIX_B])]
    q_a, k_a, v_a, q_b, k_b, v_b = jnp.split(proj, cuts, axis=-1)
    heads = lambda t: t.reshape(B, S, -1, HEAD_DIM)
    q_a = partial_rotary(rms_norm(heads(q_a), g_q_a), cos, sin)
    k_a = partial_rotary(rms_norm(heads(k_a), g_k_a), cos, sin)
    q_a = q_a.reshape(B, S, N_KV_A, N_HEADS_A // N_KV_A, HEAD_DIM)
    o_a, _ = banded_attention(q_a, k_a, heads(v_a), WINDOW_A - 1,
                              sinks_a.reshape(N_KV_A, N_HEADS_A // N_KV_A))
    o_a = rms_norm(o_a.reshape(B, S, MIX_A), g_out_a)
    q_b = partial_rotary(rms_norm(heads(q_b), g_q_b), cos, sin)
    k_b = partial_rotary(rms_norm(heads(k_b), g_k_b), cos, sin)
    o_b = dilated_attention(q_b, k_b, heads(v_b).astype(F32))
    o_b = rms_norm(o_b.reshape(B, S, MIX_B), g_out_b)
    return jnp.concatenate([o_a, o_b], axis=-1) @ w_out.astype(F32)


def swiglu(t, wg, wu, wd):
    return (jax.nn.silu(t @ wg) * (t @ wu)) @ wd


def routed_experts(xf, top_e, gates, w_gate_e, w_up_e, w_down_e):
    N, D = xf.shape
    e_flat = top_e.reshape(-1)
    NK = e_flat.shape[0]
    tok_flat = jnp.repeat(jnp.arange(N, dtype=jnp.int32), TOP_K)
    g_flat = gates.reshape(-1)
    order = jnp.argsort(e_flat)
    e_sorted = e_flat[order]
    counts = jnp.bincount(e_flat, length=N_EXPERTS)
    starts = jnp.cumsum(counts) - counts
    padded = (counts + EXPERT_BLOCK - 1) // EXPERT_BLOCK * EXPERT_BLOCK
    pends = jnp.cumsum(padded)
    pstarts = pends - padded
    dest = pstarts[e_sorted] + jnp.arange(NK) - starts[e_sorted]
    rows = -(-NK // EXPERT_BLOCK) * EXPERT_BLOCK + N_EXPERTS * EXPERT_BLOCK
    n_blocks = rows // EXPERT_BLOCK
    row_tok = jnp.zeros((rows,), jnp.int32).at[dest].set(tok_flat[order])
    row_gate = jnp.zeros((rows,), F32).at[dest].set(g_flat[order])
    block_e = jnp.minimum(
        jnp.searchsorted(pends, jnp.arange(n_blocks) * EXPERT_BLOCK, side='right'), N_EXPERTS - 1)

    def step(acc, blk):
        e, tok, g = blk
        yb = swiglu(xf[tok], w_gate_e[e], w_up_e[e], w_down_e[e])
        return acc.at[tok].add(yb.astype(F32) * g[:, None]), None

    acc, _ = lax.scan(step, jnp.zeros((N, D), F32),
                      (block_e, row_tok.reshape(n_blocks, EXPERT_BLOCK),
                       row_gate.reshape(n_blocks, EXPERT_BLOCK)))
    return acc


def moe_ffn(h, w_router, router_bias, w_gate_e, w_up_e, w_down_e, w_gate_s, w_up_s, w_down_s):
    B, S, D = h.shape
    N = B * S
    xf = h.reshape(N, D)
    scores = jax.nn.sigmoid(xf.astype(F32) @ w_router.astype(F32))
    biased = scores + router_bias.astype(F32)
    grp = lax.top_k(biased.reshape(N, N_GROUPS, N_EXPERTS // N_GROUPS), 2)[0].sum(-1)
    top_grp = lax.top_k(grp, TOPK_GROUPS)[1]
    gmask = jnp.any(top_grp[..., None] == jnp.arange(N_GROUPS), axis=1)
    emask = jnp.repeat(gmask, N_EXPERTS // N_GROUPS, axis=-1)
    _, top_e = lax.top_k(jnp.where(emask, biased, -jnp.inf), TOP_K)
    gates = jnp.take_along_axis(scores, top_e, axis=-1)
    gates = gates / jnp.sum(gates, axis=-1, keepdims=True) * ROUTED_SCALE
    routed = routed_experts(xf, top_e, gates, w_gate_e, w_up_e, w_down_e)
    shared = swiglu(xf, w_gate_s, w_up_s, w_down_s).astype(F32)
    return (routed + shared).reshape(B, S, D)


def setup_inputs(seed: int = 0) -> dict:
    key = jax.random.key(seed)
    ks = jax.random.split(key, 24)
    nrm = lambda k, shape, s: jax.random.normal(k, shape, F32) * s
    gain = lambda k, shape: 1.0 + 0.02 * jax.random.normal(k, shape, F32)
    x = jax.random.normal(ks[0], (BATCH, SEQ, D_MODEL), F32)
    c = jax.random.normal(ks[1], (BATCH, D_MODEL), F32)
    offset = jax.random.randint(ks[2], (BATCH, 1), 0, 4096, dtype=jnp.int32)
    positions = offset + jnp.arange(SEQ, dtype=jnp.int32)[None, :]
    return {
        "x": x,
        "c": c,
        "positions": positions,
        "w_ada": nrm(ks[3], (DEPTH, D_MODEL, 6 * D_MODEL), 0.25 * D_MODEL ** -0.5),
        "b_ada": nrm(ks[4], (DEPTH, 6 * D_MODEL), 0.02),
        "g_norm_mix": gain(ks[5], (DEPTH, D_MODEL)),
        "w_in": nrm(ks[6], (DEPTH, D_MODEL, IN_WIDTH), D_MODEL ** -0.5),
        "g_q_a": gain(ks[7], (DEPTH, HEAD_DIM)),
        "g_k_a": gain(ks[8], (DEPTH, HEAD_DIM)),
        "sinks_a": nrm(ks[9], (DEPTH, N_HEADS_A), 0.5),
        "g_q_b": gain(ks[10], (DEPTH, HEAD_DIM)),
        "g_k_b": gain(ks[11], (DEPTH, HEAD_DIM)),
        "g_out_a": gain(ks[12], (DEPTH, MIX_A)),
        "g_out_b": gain(ks[13], (DEPTH, MIX_B)),
        "w_out": nrm(ks[14], (DEPTH, MIX_WIDTH, D_MODEL), MIX_WIDTH ** -0.5),
        "g_norm_ffn": gain(ks[15], (DEPTH, D_MODEL)),
        "w_router": nrm(ks[16], (DEPTH, D_MODEL, N_EXPERTS), D_MODEL ** -0.5),
        "router_bias": nrm(ks[17], (DEPTH, N_EXPERTS), 0.01),
        "w_gate_e": nrm(ks[18], (DEPTH, N_EXPERTS, D_MODEL, EXPERT_DIM), D_MODEL ** -0.5),
        "w_up_e": nrm(ks[19], (DEPTH, N_EXPERTS, D_MODEL, EXPERT_DIM), D_MODEL ** -0.5),
        "w_down_e": nrm(ks[20], (DEPTH, N_EXPERTS, EXPERT_DIM, D_MODEL), EXPERT_DIM ** -0.5),
        "w_gate_s": nrm(ks[21], (DEPTH, D_MODEL, SHARED_DIM), D_MODEL ** -0.5),
        "w_up_s": nrm(ks[22], (DEPTH, D_MODEL, SHARED_DIM), D_MODEL ** -0.5),
        "w_down_s": nrm(ks[23], (DEPTH, SHARED_DIM, D_MODEL), SHARED_DIM ** -0.5),
    }


def reference(x, c, positions, w_ada, b_ada, g_norm_mix, w_in, g_q_a, g_k_a, sinks_a,
              g_q_b, g_k_b, g_out_a, g_out_b, w_out, g_norm_ffn, w_router, router_bias,
              w_gate_e, w_up_e, w_down_e, w_gate_s, w_up_s, w_down_s):
    B, S, D = x.shape
    cos, sin = rope_tables(positions)
    cond = jax.nn.silu(c.astype(F32))
    for l in range(DEPTH):
        mod = (cond @ w_ada[l].astype(F32) + b_ada[l].astype(F32)).reshape(B, 6, 1, D)
        shift_a, scale_a, gate_a = mod[:, 0], mod[:, 1], mod[:, 2]
        shift_m, scale_m, gate_m = mod[:, 3], mod[:, 4], mod[:, 5]
        h = (rms_norm(x, g_norm_mix[l]) * (1.0 + scale_a) + shift_a).astype(x.dtype)
        y = hybrid_mixer(h, cos, sin, w_in[l], g_q_a[l], g_k_a[l], sinks_a[l],
                         g_q_b[l], g_k_b[l], g_out_a[l], g_out_b[l], w_out[l])
        x = (x.astype(F32) + gate_a * y).astype(x.dtype)
        h = (rms_norm(x, g_norm_ffn[l]) * (1.0 + scale_m) + shift_m).astype(x.dtype)
        y = moe_ffn(h, w_router[l], router_bias[l], w_gate_e[l], w_up_e[l], w_down_e[l],
                    w_gate_s[l], w_up_s[l], w_down_s[l])
        x = (x.astype(F32) + gate_m * y).astype(x.dtype)
    return x
```

```cpp
#include <hip/hip_runtime.h>
#include <stdint.h>
#include <cstdio>

#ifndef FUSED
#define FUSED 1
#endif

typedef __bf16 bf16;
typedef __attribute__((ext_vector_type(8))) __bf16 bf16x8;
typedef __attribute__((ext_vector_type(4))) __bf16 bf16x4;
typedef __attribute__((ext_vector_type(16))) float f32x16;
typedef __attribute__((ext_vector_type(4))) float f32x4;
typedef __attribute__((ext_vector_type(4))) short s16x4;
typedef __attribute__((ext_vector_type(8))) short s16x8;
#define LAS __attribute__((address_space(3)))
#define DI __device__ __forceinline__
#define MFMA32(a, b, c) __builtin_amdgcn_mfma_f32_32x32x16_bf16((a), (b), (c), 0, 0, 0)

constexpr int NB = 8, SEQ = 2048, DM = 1024, NTOK = NB * SEQ, INW = 2304;
constexpr int KA_OFF = 512, VA_OFF = 640, QB_OFF = 768, KB_OFF = 1280, VB_OFF = 1792;
constexpr int NE = 256, ED = 256, LCAP = NTOK;
constexpr float EPS = 1e-6f;
constexpr int NTHR = 512, NWAVE = 8;
constexpr int PITCH = 2064;
constexpr int LDS_BYTES = 155648;
constexpr int LDS_MISC = 64 * PITCH;
constexpr int LDS_BARW = LDS_BYTES - 16;

constexpr size_t WS_CTL = 0;
constexpr size_t CTL_BYTES = 65536;
constexpr size_t CTL_CNT = 32768;
constexpr size_t WS_MODP = WS_CTL + CTL_BYTES;
constexpr size_t WS_MODF = WS_MODP + 8ull * 8 * 6144 * 4;
constexpr size_t WS_ROPE = WS_MODF + 8ull * 6144 * 4;
constexpr size_t WS_WIN = WS_ROPE + 2ull * NTOK * 8 * 4;
constexpr size_t WS_WOUT = WS_WIN + (size_t)INW * DM * 2;
constexpr size_t WS_WR = WS_WOUT + (size_t)DM * DM * 2;
constexpr size_t WS_WGS = WS_WR + (size_t)NE * DM * 2;
constexpr size_t WS_WUS = WS_WGS + (size_t)256 * DM * 2;
constexpr size_t WS_WDS = WS_WUS + (size_t)256 * DM * 2;
constexpr size_t WS_QKV = WS_WDS + (size_t)256 * DM * 2;
constexpr size_t WS_OA = WS_QKV + (size_t)NTOK * INW * 2;
constexpr size_t WS_OB = WS_OA + (size_t)NTOK * 512 * 2;
constexpr size_t WS_LSE = WS_OB + 3ull * NTOK * 512 * 2;
constexpr size_t WS_H2 = WS_LSE + 3ull * NTOK * 8 * 4;
constexpr size_t WS_LOG = WS_H2 + (size_t)NTOK * DM * 2;
constexpr size_t WS_GATE = WS_LOG + (size_t)NTOK * NE * 4;
constexpr size_t WS_LIST = WS_GATE + (size_t)NTOK * 8 * 4;
constexpr size_t WS_Y = WS_LIST + (size_t)NE * LCAP * 4;
constexpr size_t WS_END = WS_Y + (size_t)NTOK * 8 * DM * 2;

struct Params {
    const float *x, *c; const int* pos;
    const float *w_ada, *b_ada, *g_mix, *w_in, *g_q_a, *g_k_a, *sinks, *g_q_b, *g_k_b, *g_out_a, *g_out_b, *w_out, *g_ffn, *w_router, *r_bias;
    const float *w_gate_e, *w_up_e, *w_down_e, *w_gate_s, *w_up_s, *w_down_s;
    float* out; unsigned char* ws;
};

DI float shx(float v, int mask, int lane) { return __builtin_bit_cast(float, __builtin_amdgcn_ds_bpermute((lane ^ mask) << 2, __builtin_bit_cast(int, v))); }
DI int shxi(int v, int mask, int lane) { return __builtin_amdgcn_ds_bpermute((lane ^ mask) << 2, v); }
DI float shidx(float v, int src, int lane) { (void)lane; return __builtin_bit_cast(float, __builtin_amdgcn_ds_bpermute(src << 2, __builtin_bit_cast(int, v))); }
DI float wave_sum(float v, int lane) {
#pragma unroll
    for (int o = 1; o < 64; o <<= 1) v += shx(v, o, lane);
    return v;
}
DI int lane_opaque() { int l = (int)__builtin_amdgcn_mbcnt_hi(~0u, __builtin_amdgcn_mbcnt_lo(~0u, 0u)); asm volatile("" : "+v"(l)); return l; }
DI int wid_opaque(int wid) { int w = wid; asm volatile("" : "+s"(w)); return w; }
DI int tid_of(int wid) { return wid_opaque(wid) * 64 + lane_opaque(); }
DI int crow(int r, int h) { return (r & 3) + 8 * (r >> 2) + 4 * h; }
DI float silu_f(float v) { return v / (1.f + __expf(-v)); }
DI float mod_val(const Params& p, int b, int idx) {
    const float* mp = (const float*)(p.ws + WS_MODP);
    float s = p.b_ada[idx];
#pragma unroll
    for (int ks = 0; ks < 8; ++ks) s += mp[(size_t)(ks * 8 + b) * 6144 + idx];
    return s;
}
DI bf16x4 pack4(float a, float b, float c, float d) { bf16x4 v; v[0] = (bf16)a; v[1] = (bf16)b; v[2] = (bf16)c; v[3] = (bf16)d; return v; }

#define XB_TMO      128
#define XB_XCNT(j)  (256  + 64 * (j))
#define XB_XSUB(j)  (1280 + 64 * (j))
#define XB_XGEN(j)  (2304 + 64 * (j))
#define XB_TOP      3328
#define XB_TOPGEN   3392
#define XCD_BAR_WORDS 3456
#define XB_SPIN_CAP (1u << 22)
DI unsigned xb_ld(unsigned* p) { return __hip_atomic_load(p, __ATOMIC_RELAXED, __HIP_MEMORY_SCOPE_AGENT); }
DI unsigned xb_add(unsigned* p, unsigned v) { return __hip_atomic_fetch_add(p, v, __ATOMIC_RELAXED, __HIP_MEMORY_SCOPE_AGENT); }
DI unsigned xb_xcc_id() { return (unsigned)__builtin_amdgcn_s_getreg((3 << 11) | 20) & 0xFu; }
#define XB_SPIN(cond, bar) do { unsigned _sp = 0; while (cond) { __builtin_amdgcn_s_sleep(1); \
    if ((++_sp & 255u) == 0u) { if (xb_ld(&(bar)[XB_TMO])) break; if (_sp > XB_SPIN_CAP) { atomicAdd(&(bar)[XB_TMO], 1u); break; } } } } while (0)
struct XcdBarrier { unsigned* bar; unsigned x; volatile LAS unsigned* st; int wid; };
DI XcdBarrier xcd_barrier_post(unsigned* bar, volatile LAS unsigned* st, int wid) {
    XcdBarrier b; b.bar = bar; b.x = xb_xcc_id(); b.st = st; b.wid = wid;
    if (tid_of(wid) == 0) (void)xb_add(&bar[XB_XCNT(b.x)], 1u);
    return b;
}
DI void xcd_barrier_complete(unsigned* bar, unsigned x, unsigned& nloc, unsigned& nx) {
    const unsigned G = gridDim.x * gridDim.y * gridDim.z;
    unsigned sum, cnt, mine, sp = 0u;
    for (;;) {
        sum = 0u; cnt = 0u; mine = 0u;
#pragma unroll
        for (unsigned j = 0; j < 16; ++j) { const unsigned c = xb_ld(&bar[XB_XCNT(j)]); sum += c; cnt += (c > 0u) ? 1u : 0u; mine = (j == x) ? c : mine; }
        if (sum == G) break;
        __builtin_amdgcn_s_sleep(1);
        if ((++sp & 255u) == 0u) { if (xb_ld(&bar[XB_TMO])) break; if (sp > XB_SPIN_CAP) { atomicAdd(&bar[XB_TMO], 1u); break; } }
    }
    nloc = mine > 0u ? mine : 1u; nx = cnt > 0u ? cnt : 1u;
}
DI void xcd_barrier(const XcdBarrier& b) {
    asm volatile("s_waitcnt vmcnt(0)" ::: "memory");
    __syncthreads();
    if (tid_of(b.wid) == 0) {
        unsigned* bar = b.bar;
        __builtin_amdgcn_s_waitcnt(0);
        unsigned nloc = b.st[0], nx = b.st[1];
        if (nloc == 0u) { xcd_barrier_complete(bar, b.x, nloc, nx); b.st[0] = nloc; b.st[1] = nx; }
        const unsigned old = xb_add(&bar[XB_XSUB(b.x)], 1u);
        const unsigned gen = old / nloc;
        if (old + 1u == (gen + 1u) * nloc) {
            __builtin_amdgcn_fence(__ATOMIC_RELEASE, "agent");
            asm volatile("s_waitcnt vmcnt(0)" ::: "memory");
            const unsigned og = xb_add(&bar[XB_TOP], 1u);
            const unsigned tg = og / nx;
            if (og + 1u == (tg + 1u) * nx) xb_add(&bar[XB_TOPGEN], 1u);
            else XB_SPIN(xb_ld(&bar[XB_TOPGEN]) == tg, bar);
            __builtin_amdgcn_fence(__ATOMIC_ACQUIRE, "agent");
            xb_add(&bar[XB_XGEN(b.x)], 1u);
            asm volatile("s_waitcnt vmcnt(0)" ::: "memory");
        } else {
            XB_SPIN(xb_ld(&bar[XB_XGEN(b.x)]) == gen, bar);
            __builtin_amdgcn_fence(__ATOMIC_ACQUIRE, "agent");
            asm volatile("s_waitcnt vmcnt(0)" ::: "memory");
        }
    }
    __syncthreads();
}

template <int NT, int KS>
DI void gemm_ct(f32x16 (&acc)[NT][2], const bf16x8* const (&wp)[NT], const LAS char* panel, int pitch, int lane) {
    const LAS char* b0 = panel + (lane & 31) * pitch + (lane >> 5) * 16;
    const LAS char* b1 = b0 + 32 * pitch;
    constexpr int PF = (NT >= 4) ? 2 : 4;
    bf16x8 w[PF][NT];
#pragma unroll
    for (int q = 0; q < PF; ++q)
#pragma unroll
        for (int i = 0; i < NT; ++i) w[q][i] = wp[i][q * 64];
#pragma unroll 1
    for (int ks0 = 0; ks0 < KS; ks0 += PF) {
#pragma unroll
        for (int q = 0; q < PF; ++q) {
            const int ks = ks0 + q;
            bf16x8 a[NT];
#pragma unroll
            for (int i = 0; i < NT; ++i) a[i] = w[q][i];
            if (ks + PF < KS) {
#pragma unroll
                for (int i = 0; i < NT; ++i) w[q][i] = wp[i][(ks + PF) * 64];
            }
            const bf16x8 t0 = *(const LAS bf16x8*)(b0 + ks * 32);
            const bf16x8 t1 = *(const LAS bf16x8*)(b1 + ks * 32);
#pragma unroll
            for (int i = 0; i < NT; ++i) { acc[i][0] = MFMA32(a[i], t0, acc[i][0]); acc[i][1] = MFMA32(a[i], t1, acc[i][1]); }
        }
    }
}
template <int NT> DI void zero_acc(f32x16 (&acc)[NT][2]) {
#pragma unroll
    for (int i = 0; i < NT; ++i)
#pragma unroll
        for (int t = 0; t < 2; ++t)
#pragma unroll
            for (int r = 0; r < 16; ++r) acc[i][t][r] = 0.f;
}

DI void convert_sw(const float* W, int K, int N, bf16x8* dst, const float* sa, const float* sb, int gtid, int gthreads) {
    const int KS = K / 16, total = (N / 32) * KS * 64;
    for (int pc = gtid; pc < total; pc += gthreads) {
        const int l = pc & 63, ks = (pc >> 6) % KS, nt = (pc >> 6) / KS;
        const int n = 32 * nt + (l & 31), k0 = 16 * ks + 8 * (l >> 5);
        bf16x8 v;
#pragma unroll
        for (int j = 0; j < 8; ++j) {
            float w = W[(size_t)(k0 + j) * N + n];
            if (sa) { const int k = k0 + j; w *= (k < 512) ? sa[k] : sb[k - 512]; }
            v[j] = (bf16)w;
        }
        dst[pc] = v;
    }
}
DI void phase0(const Params& p, LAS char* lds, int vcu, int G, int wid) {
    const int lane = lane_opaque(), wv = wid_opaque(wid), tid = wv * 64 + lane;
    LAS float* red = (LAS float*)lds;
    for (int it = vcu; it < 96 * 8; it += G) {
        const int cc = it % 96, ks = it / 96;
        float acc[8];
#pragma unroll
        for (int b = 0; b < 8; ++b) acc[b] = 0.f;
        const int n = 64 * cc + lane;
        for (int i = 0; i < 16; ++i) {
            const int k = 128 * ks + 16 * wv + i;
            const float w = p.w_ada[(size_t)k * 6144 + n];
#pragma unroll
            for (int b = 0; b < 8; ++b) acc[b] += silu_f(p.c[b * DM + k]) * w;
        }
#pragma unroll
        for (int b = 0; b < 8; ++b) red[(wv * 8 + b) * 64 + lane] = acc[b];
        __syncthreads();
        {
            const int b = tid >> 6, col = tid & 63;
            float s = 0.f;
#pragma unroll
            for (int w8 = 0; w8 < 8; ++w8) s += red[(w8 * 8 + b) * 64 + col];
            ((float*)(p.ws + WS_MODP))[(size_t)(ks * 8 + b) * 6144 + 64 * cc + col] = s;
        }
        __syncthreads();
    }
    const int gtid = vcu * NTHR + tid, gth = G * NTHR;
    convert_sw(p.w_in, DM, INW, (bf16x8*)(p.ws + WS_WIN), nullptr, nullptr, gtid, gth);
    convert_sw(p.w_out, DM, DM, (bf16x8*)(p.ws + WS_WOUT), p.g_out_a, p.g_out_b, gtid, gth);
    convert_sw(p.w_router, DM, NE, (bf16x8*)(p.ws + WS_WR), nullptr, nullptr, gtid, gth);
    convert_sw(p.w_gate_s, DM, 256, (bf16x8*)(p.ws + WS_WGS), nullptr, nullptr, gtid, gth);
    convert_sw(p.w_up_s, DM, 256, (bf16x8*)(p.ws + WS_WUS), nullptr, nullptr, gtid, gth);
    convert_sw(p.w_down_s, 256, DM, (bf16x8*)(p.ws + WS_WDS), nullptr, nullptr, gtid, gth);
    float* cosT = (float*)(p.ws + WS_ROPE); float* sinT = cosT + (size_t)NTOK * 8;
    for (int e = gtid; e < NTOK * 8; e += gth) {
        const int t = e >> 3, i = e & 7;
        const float inv = (float)exp2(-(double)i * 0.125 * 18.931568569324174);
        const float ang = (float)p.pos[t] * inv;
        double rev = (double)ang * 0.15915494309189535; rev -= floor(rev);
        cosT[e] = __builtin_amdgcn_cosf((float)rev);
        sinT[e] = __builtin_amdgcn_sinf((float)rev);
    }
}

DI void phase1(const Params& p, LAS char* lds, int wg, int wid) {
    const int lane = lane_opaque(), wv = wid_opaque(wid), tid = wv * 64 + lane;
    const int t0 = wg * 64, b = t0 / SEQ;
    if (tid < 192) { const int idx = (wg & 31) * 192 + tid; ((float*)(p.ws + WS_MODF))[b * 6144 + idx] = mod_val(p, b, idx); }
    {
        float ga[16], sh[16];
#pragma unroll
        for (int j = 0; j < 4; ++j)
#pragma unroll
            for (int e = 0; e < 4; ++e) {
                const int k = 256 * j + 4 * lane + e;
                ga[4 * j + e] = p.g_mix[k] * (1.f + mod_val(p, b, 1 * DM + k));
                sh[4 * j + e] = mod_val(p, b, 0 * DM + k);
            }
#pragma unroll 1
        for (int i = 0; i < 8; ++i) {
            const int row = 8 * wv + i;
            const float* xr = p.x + (size_t)(t0 + row) * DM;
            f32x4 v[4]; float ss = 0.f;
#pragma unroll
            for (int j = 0; j < 4; ++j) { v[j] = *(const f32x4*)(xr + 256 * j + 4 * lane); ss += v[j][0] * v[j][0] + v[j][1] * v[j][1] + v[j][2] * v[j][2] + v[j][3] * v[j][3]; }
            const float rstd = rsqrtf(wave_sum(ss, lane) * (1.f / DM) + EPS);
#pragma unroll
            for (int j = 0; j < 4; ++j) {
                const bf16x4 o = pack4(v[j][0] * rstd * ga[4 * j] + sh[4 * j], v[j][1] * rstd * ga[4 * j + 1] + sh[4 * j + 1],
                                       v[j][2] * rstd * ga[4 * j + 2] + sh[4 * j + 2], v[j][3] * rstd * ga[4 * j + 3] + sh[4 * j + 3]);
                *(LAS bf16x4*)(lds + row * PITCH + (256 * j + 4 * lane) * 2) = o;
            }
        }
    }
    __syncthreads();
    const bf16x8* wsw = (const bf16x8*)(p.ws + WS_WIN);
    const float* cosT = (const float*)(p.ws + WS_ROPE); const float* sinT = cosT + (size_t)NTOK * 8;
    bf16* qkv = (bf16*)(p.ws + WS_QKV);
    const int h = lane >> 5;
#pragma unroll 1
    for (int u = wv; u < 36; u += NWAVE) {
        f32x16 acc[2][2]; zero_acc<2>(acc);
        const bf16x8* wp[2] = { wsw + (size_t)(2 * u) * 64 * 64 + lane, wsw + (size_t)(2 * u + 1) * 64 * 64 + lane };
        gemm_ct<2, 64>(acc, wp, lds, PITCH, lane);
        const float* g = nullptr; float qs = 1.f;
        if (u < 8) { g = p.g_q_a; qs = 0.125f; } else if (u < 10) g = p.g_k_a; else if (u >= 12 && u < 20) { g = p.g_q_b; qs = 0.125f; } else if (u >= 20 && u < 28) g = p.g_k_b;
#pragma unroll
        for (int tt = 0; tt < 2; ++tt) {
            const int tok = t0 + 32 * tt + (lane & 31);
            if (g) {
                float ss = 0.f;
#pragma unroll
                for (int nt = 0; nt < 2; ++nt)
#pragma unroll
                    for (int r = 0; r < 16; ++r) ss += acc[nt][tt][r] * acc[nt][tt][r];
                ss += shx(ss, 32, lane);
                const float rstd = rsqrtf(ss * (1.f / 64.f) + EPS);
#pragma unroll
                for (int nt = 0; nt < 2; ++nt)
#pragma unroll
                    for (int r = 0; r < 16; ++r) acc[nt][tt][r] *= rstd * g[32 * nt + crow(r, h)];
#pragma unroll
                for (int r = 0; r < 4; ++r) {
                    const int i = r + 4 * h;
                    const float cs = cosT[(size_t)tok * 8 + i], sn = sinT[(size_t)tok * 8 + i];
                    const float a1 = acc[0][tt][r], a2 = acc[0][tt][r + 4];
                    acc[0][tt][r] = a1 * cs - a2 * sn; acc[0][tt][r + 4] = a2 * cs + a1 * sn;
                }
            }
#pragma unroll
            for (int nt = 0; nt < 2; ++nt)
#pragma unroll
                for (int g4 = 0; g4 < 4; ++g4) {
                    const bf16x4 o = pack4(acc[nt][tt][4 * g4] * qs, acc[nt][tt][4 * g4 + 1] * qs, acc[nt][tt][4 * g4 + 2] * qs, acc[nt][tt][4 * g4 + 3] * qs);
                    *(bf16x4*)(qkv + (size_t)tok * INW + 64 * u + 32 * nt + 8 * g4 + 4 * h) = o;
                }
        }
    }
}

constexpr int VP = 192;
DI void attn_unit(const Params& p, LAS char* vimg, int u, int lane) {
    const int combo = u & 31, blk = (u >> 5) & 31, b = u >> 10;
    const int h = lane >> 5, l31 = lane & 31;
    int qoff, koff, voff, dil, maxd; float m_init, l_init; bf16* outp; float* lsep = nullptr; int hb;
    if (combo < 8) {
        hb = combo; qoff = 64 * hb; koff = KA_OFF + 64 * (hb >> 2); voff = VA_OFF + 64 * (hb >> 2); dil = 1; maxd = 127;
        m_init = p.sinks[hb]; l_init = 1.f; outp = (bf16*)(p.ws + WS_OA);
    } else {
        const int br = (combo - 8) >> 3; hb = (combo - 8) & 7;
        qoff = QB_OFF + 64 * hb; koff = KB_OFF + 64 * hb; voff = VB_OFF + 64 * hb; dil = (br == 0) ? 1 : (br == 1 ? 4 : 16); maxd = 128;
        m_init = -1e30f; l_init = 0.f; outp = (bf16*)(p.ws + WS_OB) + (size_t)br * NTOK * 512; lsep = (float*)(p.ws + WS_LSE) + (size_t)br * NTOK * 8;
    }
    const int L = SEQ / dil, nb = L / 64, rho = blk / nb, l0 = (blk % nb) * 64;
    const bf16* qkv = (const bf16*)(p.ws + WS_QKV) + (size_t)b * SEQ * INW;
    bf16x8 qf[2][4];
#pragma unroll
    for (int qt = 0; qt < 2; ++qt) {
        const bf16* qp = qkv + (size_t)((l0 + 32 * qt + l31) * dil + rho) * INW + qoff + 8 * h;
#pragma unroll
        for (int s = 0; s < 4; ++s) qf[qt][s] = *(const bf16x8*)(qp + 16 * s);
    }
    f32x16 o[2][2];
#pragma unroll
    for (int dt = 0; dt < 2; ++dt)
#pragma unroll
        for (int qt = 0; qt < 2; ++qt)
#pragma unroll
            for (int r = 0; r < 16; ++r) o[dt][qt][r] = 0.f;
    float mrun[2] = { m_init, m_init }, lrun[2] = { h == 0 ? l_init : 0.f, h == 0 ? l_init : 0.f };
    const float LOG2E = 1.4426950408889634f;
#pragma unroll 1
    for (int kt = 0; kt < 6; ++kt) {
        const int lk0 = l0 - 128 + 32 * kt;
        if (lk0 + 31 < 0) continue;
        bf16x8 kf[4];
        {
            int lk = lk0 + l31; lk = lk < 0 ? 0 : lk;
            const bf16* kp = qkv + (size_t)(lk * dil + rho) * INW + koff + 8 * h;
#pragma unroll
            for (int s = 0; s < 4; ++s) kf[s] = *(const bf16x8*)(kp + 16 * s);
        }
        {
            bf16x8 vr[4];
#pragma unroll
            for (int i = 0; i < 4; ++i) {
                int lk = lk0 + (lane >> 3) + 8 * i; lk = lk < 0 ? 0 : lk;
                vr[i] = *(const bf16x8*)(qkv + (size_t)(lk * dil + rho) * INW + voff + 8 * (lane & 7));
            }
#pragma unroll
            for (int i = 0; i < 4; ++i) *(LAS bf16x8*)(vimg + ((lane >> 3) + 8 * i) * VP + 16 * (lane & 7)) = vr[i];
        }
        bf16x8 vf[2][2];
        {
            const int g1 = (lane >> 4) & 1, q4 = (lane & 15) >> 2, p4 = lane & 3;
#pragma unroll
            for (int dt = 0; dt < 2; ++dt)
#pragma unroll
                for (int s = 0; s < 2; ++s) {
                    const LAS char* a0 = vimg + (16 * s + 4 * h + q4) * VP + (32 * dt + 16 * g1 + 4 * p4) * 2;
                    const s16x4 lo = __builtin_amdgcn_ds_read_tr16_b64_v4i16((LAS s16x4*)a0);
                    const s16x4 hi = __builtin_amdgcn_ds_read_tr16_b64_v4i16((LAS s16x4*)(a0 + 8 * VP));
                    const s16x8 c = __builtin_shufflevector(lo, hi, 0, 1, 2, 3, 4, 5, 6, 7);
                    vf[dt][s] = __builtin_bit_cast(bf16x8, c);
                }
        }
#pragma unroll
        for (int qt = 0; qt < 2; ++qt) {
            if ((qt == 0 && kt == 5) || (qt == 1 && kt == 0)) continue;
            f32x16 sacc;
#pragma unroll
            for (int r = 0; r < 16; ++r) sacc[r] = 0.f;
#pragma unroll
            for (int s = 0; s < 4; ++s) sacc = MFMA32(kf[s], qf[qt][s], sacc);
            const int lq = l0 + 32 * qt + l31;
            float mx = -1e30f;
#pragma unroll
            for (int r = 0; r < 16; ++r) {
                const int lk = lk0 + crow(r, h), d = lq - lk;
                const bool ok = (lk >= 0) && (d >= 0) && (d <= maxd);
                sacc[r] = ok ? sacc[r] : -1e30f;
                mx = fmaxf(mx, sacc[r]);
            }
            mx = fmaxf(mx, shx(mx, 32, lane));
            const float mnew = fmaxf(mrun[qt], mx);
            const float alpha = exp2f((mrun[qt] - mnew) * LOG2E);
            float ps = 0.f;
#pragma unroll
            for (int r = 0; r < 16; ++r) { sacc[r] = exp2f((sacc[r] - mnew) * LOG2E); ps += sacc[r]; }
            lrun[qt] = lrun[qt] * alpha + ps; mrun[qt] = mnew;
#pragma unroll
            for (int dt = 0; dt < 2; ++dt)
#pragma unroll
                for (int r = 0; r < 16; ++r) o[dt][qt][r] *= alpha;
            bf16x8 pf[2];
#pragma unroll
            for (int s = 0; s < 2; ++s)
#pragma unroll
                for (int j = 0; j < 8; ++j) pf[s][j] = (bf16)sacc[8 * s + j];
#pragma unroll
            for (int dt = 0; dt < 2; ++dt)
#pragma unroll
                for (int s = 0; s < 2; ++s) o[dt][qt] = MFMA32(vf[dt][s], pf[s], o[dt][qt]);
        }
    }
#pragma unroll
    for (int qt = 0; qt < 2; ++qt) {
        const float lt = lrun[qt] + shx(lrun[qt], 32, lane);
        const float inv = 1.f / lt;
        const size_t tok = (size_t)b * SEQ + (size_t)(l0 + 32 * qt + l31) * dil + rho;
#pragma unroll
        for (int dt = 0; dt < 2; ++dt)
#pragma unroll
            for (int g4 = 0; g4 < 4; ++g4) {
                const bf16x4 v = pack4(o[dt][qt][4 * g4] * inv, o[dt][qt][4 * g4 + 1] * inv, o[dt][qt][4 * g4 + 2] * inv, o[dt][qt][4 * g4 + 3] * inv);
                *(bf16x4*)(outp + tok * 512 + 64 * hb + 32 * dt + 8 * g4 + 4 * h) = v;
            }
        if (lsep && h == 0) lsep[tok * 8 + hb] = mrun[qt] + logf(lt);
    }
}
DI void phase2(const Params& p, LAS char* lds, int vcu, int G, int wid) {
    const int lane = lane_opaque(), wv = wid_opaque(wid), tid = wv * 64 + lane;
    LAS char* vimg = lds + wv * (32 * VP);
    for (int u = vcu * NWAVE + wv; u < 8192; u += G * NWAVE) attn_unit(p, vimg, u, lane);
}

DI void phase3(const Params& p, LAS char* lds, int wg, int wid) {
    const int lane = lane_opaque(), wv = wid_opaque(wid), tid = wv * 64 + lane, h = lane >> 5, l31 = lane & 31;
    const int t0 = wg * 64, b = t0 / SEQ;
    LAS float* ga_l = (LAS float*)(lds + LDS_MISC + 2048);
    LAS float* hs_l = ga_l + 1024;
    LAS float* sh_l = hs_l + 1024;
    LAS float* gm_l = sh_l + 1024;
    {
        const float* mf = (const float*)(p.ws + WS_MODF) + b * 6144;
        for (int n = tid; n < DM; n += NTHR) { ga_l[n] = mf[2 * DM + n]; hs_l[n] = p.g_ffn[n] * (1.f + mf[4 * DM + n]); sh_l[n] = mf[3 * DM + n]; gm_l[n] = mf[5 * DM + n]; }
    }
    {
        const bf16* oa = (const bf16*)(p.ws + WS_OA); const bf16* ob = (const bf16*)(p.ws + WS_OB); const float* lse = (const float*)(p.ws + WS_LSE);
#pragma unroll 1
        for (int i = 0; i < 8; ++i) {
            const int row = 8 * wv + i; const size_t tok = t0 + row;
            float v[16];
            if (h == 0) {
                const bf16x8 a0 = *(const bf16x8*)(oa + tok * 512 + 16 * l31), a1 = *(const bf16x8*)(oa + tok * 512 + 16 * l31 + 8);
#pragma unroll
                for (int j = 0; j < 8; ++j) { v[j] = (float)a0[j]; v[8 + j] = (float)a1[j]; }
            } else {
                const int hd = l31 >> 2;
                const float e0 = lse[tok * 8 + hd], e1 = lse[(size_t)NTOK * 8 + tok * 8 + hd], e2 = lse[(size_t)2 * NTOK * 8 + tok * 8 + hd];
                const float mx = fmaxf(e0, fmaxf(e1, e2));
                float w0 = __expf(e0 - mx), w1 = __expf(e1 - mx), w2 = __expf(e2 - mx);
                const float wi = 1.f / (w0 + w1 + w2); w0 *= wi; w1 *= wi; w2 *= wi;
#pragma unroll
                for (int j = 0; j < 16; ++j) v[j] = 0.f;
#pragma unroll
                for (int br = 0; br < 3; ++br) {
                    const bf16* src = ob + (size_t)br * NTOK * 512 + tok * 512 + 16 * l31;
                    const bf16x8 a0 = *(const bf16x8*)src, a1 = *(const bf16x8*)(src + 8);
                    const float w = br == 0 ? w0 : (br == 1 ? w1 : w2);
#pragma unroll
                    for (int j = 0; j < 8; ++j) { v[j] += w * (float)a0[j]; v[8 + j] += w * (float)a1[j]; }
                }
            }
            float ss = 0.f;
#pragma unroll
            for (int j = 0; j < 16; ++j) ss += v[j] * v[j];
#pragma unroll
            for (int o2 = 1; o2 < 32; o2 <<= 1) ss += shx(ss, o2, lane);
            const float rstd = rsqrtf(ss * (1.f / 512.f) + EPS);
            bf16x8 o0, o1;
#pragma unroll
            for (int j = 0; j < 8; ++j) { o0[j] = (bf16)(v[j] * rstd); o1[j] = (bf16)(v[8 + j] * rstd); }
            LAS char* dst = lds + row * PITCH + (512 * h + 16 * l31) * 2;
            *(LAS bf16x8*)dst = o0; *(LAS bf16x8*)(dst + 16) = o1;
        }
    }
    __syncthreads();
    f32x16 x1[4][2]; zero_acc<4>(x1);
    {
        const bf16x8* wsw = (const bf16x8*)(p.ws + WS_WOUT);
        const bf16x8* wp[4];
#pragma unroll
        for (int i = 0; i < 4; ++i) wp[i] = wsw + (size_t)(4 * wv + i) * 64 * 64 + lane;
        gemm_ct<4, 64>(x1, wp, lds, PITCH, lane);
    }
    LAS float* ssx = (LAS float*)(lds + LDS_MISC);
#pragma unroll
    for (int tt = 0; tt < 2; ++tt) {
        const size_t tok = t0 + 32 * tt + l31;
        float ss = 0.f;
#pragma unroll
        for (int i = 0; i < 4; ++i)
#pragma unroll
            for (int g4 = 0; g4 < 4; ++g4) {
                const int n = 128 * wv + 32 * i + 8 * g4 + 4 * h;
                const f32x4 xv = *(const f32x4*)(p.x + tok * DM + n);
                f32x4 ov;
#pragma unroll
                for (int e = 0; e < 4; ++e) {
                    const float v = xv[e] + ga_l[n + e] * x1[i][tt][4 * g4 + e];
                    x1[i][tt][4 * g4 + e] = v; ov[e] = v; ss += v * v;
                }
                *(f32x4*)(p.out + tok * DM + n) = ov;
                __builtin_amdgcn_sched_barrier(0);
            }
        ss += shx(ss, 32, lane);
        if (h == 0) ssx[wv * 64 + 32 * tt + l31] = ss;
    }
    __syncthreads();
    {
        bf16* h2g = (bf16*)(p.ws + WS_H2);
#pragma unroll
        for (int tt = 0; tt < 2; ++tt) {
            const int row = 32 * tt + l31; const size_t tok = t0 + row;
            float ss = 0.f;
#pragma unroll
            for (int w8 = 0; w8 < 8; ++w8) ss += ssx[w8 * 64 + row];
            const float rstd = rsqrtf(ss * (1.f / DM) + EPS);
#pragma unroll
            for (int i = 0; i < 4; ++i)
#pragma unroll
                for (int g4 = 0; g4 < 4; ++g4) {
                    const int n = 128 * wv + 32 * i + 8 * g4 + 4 * h;
                    float hv[4];
#pragma unroll
                    for (int e = 0; e < 4; ++e)
                        hv[e] = x1[i][tt][4 * g4 + e] * rstd * hs_l[n + e] + sh_l[n + e];
                    const bf16x4 o = pack4(hv[0], hv[1], hv[2], hv[3]);
                    *(LAS bf16x4*)(lds + row * PITCH + n * 2) = o;
                    *(bf16x4*)(h2g + tok * DM + n) = o;
                    __builtin_amdgcn_sched_barrier(0);
                }
        }
    }
    __syncthreads();
    float* logit = (float*)(p.ws + WS_LOG);
    {
        f32x16 ra[1][2]; zero_acc<1>(ra);
        const bf16x8* wp[1] = { (const bf16x8*)(p.ws + WS_WR) + (size_t)wv * 64 * 64 + lane };
        gemm_ct<1, 64>(ra, wp, lds, PITCH, lane);
#pragma unroll
        for (int tt = 0; tt < 2; ++tt) {
            const size_t tok = t0 + 32 * tt + l31;
#pragma unroll
            for (int g4 = 0; g4 < 4; ++g4) {
                f32x4 v = { ra[0][tt][4 * g4], ra[0][tt][4 * g4 + 1], ra[0][tt][4 * g4 + 2], ra[0][tt][4 * g4 + 3] };
                *(f32x4*)(logit + tok * NE + 32 * wv + 8 * g4 + 4 * h) = v;
            }
        }
    }
    f32x16 gu[2][2]; zero_acc<2>(gu);
    {
        const bf16x8* wp[2] = { (const bf16x8*)(p.ws + WS_WGS) + (size_t)wv * 64 * 64 + lane, (const bf16x8*)(p.ws + WS_WUS) + (size_t)wv * 64 * 64 + lane };
        gemm_ct<2, 64>(gu, wp, lds, PITCH, lane);
    }
    __syncthreads();
    constexpr int AP = 528;
#pragma unroll
    for (int tt = 0; tt < 2; ++tt)
#pragma unroll
        for (int g4 = 0; g4 < 4; ++g4) {
            float a[4];
#pragma unroll
            for (int e = 0; e < 4; ++e) a[e] = silu_f(gu[0][tt][4 * g4 + e]) * gu[1][tt][4 * g4 + e];
            *(LAS bf16x4*)(lds + (32 * tt + l31) * AP + (32 * wv + 8 * g4 + 4 * h) * 2) = pack4(a[0], a[1], a[2], a[3]);
        }
    {
        const int lane = lane_opaque(); int t0y = t0; asm volatile("" : "+s"(t0y));
        const int g = lane & 7; const size_t tok = t0y + 8 * wv + (lane >> 3);
        float bia[32], sc[32];
        const float* lp = logit + tok * NE + 32 * g;
#pragma unroll
        for (int j = 0; j < 8; ++j) {
            const f32x4 v = __builtin_nontemporal_load((const f32x4*)(lp + 4 * j));
#pragma unroll
            for (int e = 0; e < 4; ++e) { const float s = 1.f / (1.f + expf(-v[e])); sc[4 * j + e] = s; bia[4 * j + e] = s + p.r_bias[32 * g + 4 * j + e]; }
        }
        float m1 = -INFINITY, m2 = -INFINITY;
#pragma unroll
        for (int j = 0; j < 32; ++j) { const float v = bia[j]; if (v > m1) { m2 = m1; m1 = v; } else if (v > m2) m2 = v; }
        const float gs = m1 + m2;
        int rank = 0;
#pragma unroll
        for (int o2 = 0; o2 < 8; ++o2) { const float og = shidx(gs, (lane & ~7) | o2, lane); rank += (og > gs || (og == gs && o2 < g)) ? 1 : 0; }
        const bool sel = rank < 4;
        unsigned taken = sel ? 0u : 0xFFFFFFFFu;
        float myscore = 0.f, ssum = 0.f; int myexp = 0;
#pragma unroll 1
        for (int k = 0; k < 8; ++k) {
            float bv = -INFINITY, bs = 0.f; int bi = 0;
#pragma unroll
            for (int j = 0; j < 32; ++j) { const bool free_ = !((taken >> j) & 1u); if (free_ && bia[j] > bv) { bv = bia[j]; bs = sc[j]; bi = j; } }
            int be = 32 * g + bi;
#pragma unroll
            for (int o2 = 1; o2 < 8; o2 <<= 1) {
                const float ov = shx(bv, o2, lane), os = shx(bs, o2, lane); const int oe = shxi(be, o2, lane);
                if (ov > bv || (ov == bv && oe < be)) { bv = ov; bs = os; be = oe; }
            }
            if ((be >> 5) == g) taken |= 1u << (be & 31);
            ssum += bs;
            if (k == g) { myscore = bs; myexp = be; }
        }
        const float gate = myscore / ssum * 2.5f;
        unsigned* cnt = (unsigned*)(p.ws + WS_CTL + CTL_CNT);
        const unsigned pos = atomicAdd(&cnt[myexp], 1u);
        const int asg = (int)tok * 8 + g;
        ((int*)(p.ws + WS_LIST))[(size_t)myexp * LCAP + pos] = asg;
        ((float*)(p.ws + WS_GATE))[asg] = gate;
    }
    __syncthreads();
    {
        f32x16 yd[4][2]; zero_acc<4>(yd);
        const bf16x8* wsw = (const bf16x8*)(p.ws + WS_WDS);
        const bf16x8* wp[4];
#pragma unroll
        for (int i = 0; i < 4; ++i) wp[i] = wsw + (size_t)(4 * wv + i) * 16 * 64 + lane;
        gemm_ct<4, 16>(yd, wp, lds, AP, lane);
        int t0x = t0; asm volatile("" : "+s"(t0x));
#pragma unroll
        for (int tt = 0; tt < 2; ++tt) {
            const size_t tok = t0x + 32 * tt + l31;
#pragma unroll
            for (int i = 0; i < 4; ++i)
#pragma unroll
                for (int g4 = 0; g4 < 4; ++g4) {
                    const int n = 128 * wv + 32 * i + 8 * g4 + 4 * h;
                    f32x4 ov = *(f32x4*)(p.out + tok * DM + n);
#pragma unroll
                    for (int e = 0; e < 4; ++e) ov[e] += gm_l[n + e] * yd[i][tt][4 * g4 + e];
                    *(f32x4*)(p.out + tok * DM + n) = ov;
                }
        }
    }
}

constexpr int EAP = 144;
constexpr int ACTP = 528;
constexpr int L4_ABUF = 0;
constexpr int L4_ACT = 36864;
constexpr int L4_ROW = L4_ACT + 128 * ACTP;
constexpr int L4_PFX = L4_ROW + 512;
DI void load_wfrag(float (&dst)[8], const float* base, int ldw) {
#pragma unroll
    for (int j = 0; j < 8; ++j) dst[j] = base[(size_t)j * ldw];
}
DI bf16x8 cvt8(const float (&s)[8]) { bf16x8 v;
#pragma unroll
    for (int j = 0; j < 8; ++j) v[j] = (bf16)s[j];
    return v; }
DI void phase4(const Params& p, LAS char* lds, int vcu, int G, int wid) {
    const int lane = lane_opaque(), wv = wid_opaque(wid), tid = wv * 64 + lane, h = lane >> 5, l31 = lane & 31;
    const unsigned* cnt = (const unsigned*)(p.ws + WS_CTL + CTL_CNT);
    LAS int* pfx = (LAS int*)(lds + L4_PFX);
    LAS int* rowasg = (LAS int*)(lds + L4_ROW);
    if (tid == 0) { int s = 0; for (int e = 0; e < NE; ++e) { pfx[e] = s; s += ((int)cnt[e] + 127) >> 7; } pfx[NE] = s; }
    __syncthreads();
    const int total = pfx[NE];
    const int* list = (const int*)(p.ws + WS_LIST);
    const bf16* h2g = (const bf16*)(p.ws + WS_H2);
    const float* gatebuf = (const float*)(p.ws + WS_GATE);
    bf16* ybuf = (bf16*)(p.ws + WS_Y);
    for (int it = vcu; it < total; it += G) {
        int lo = 0, hi = NE - 1;
        while (lo < hi) { const int mid = (lo + hi + 1) >> 1; if (pfx[mid] <= it) lo = mid; else hi = mid - 1; }
        const int e = lo, ch = it - pfx[e], nrows = min(128, (int)cnt[e] - 128 * ch);
        if (tid < 128) rowasg[tid] = list[(size_t)e * LCAP + 128 * ch + (tid < nrows ? tid : 0)];
        __syncthreads();
        const int srow = tid >> 2, spart = tid & 3;
        const bf16* arow = h2g + (size_t)(rowasg[srow] >> 3) * DM + 16 * spart;
        bf16x8 st0 = *(const bf16x8*)arow, st1 = *(const bf16x8*)(arow + 8);
        *(LAS bf16x8*)(lds + L4_ABUF + srow * EAP + 32 * spart) = st0;
        *(LAS bf16x8*)(lds + L4_ABUF + srow * EAP + 32 * spart + 16) = st1;
        f32x16 ag[4], au[4];
#pragma unroll
        for (int rt = 0; rt < 4; ++rt)
#pragma unroll
            for (int r = 0; r < 16; ++r) { ag[rt][r] = 0.f; au[rt][r] = 0.f; }
        const float* wgp = p.w_gate_e + (size_t)e * DM * ED + (size_t)(8 * h) * ED + 32 * wv + l31;
        const float* wup = p.w_up_e + (size_t)e * DM * ED + (size_t)(8 * h) * ED + 32 * wv + l31;
        float rg[2][8], ru[2][8];
        load_wfrag(rg[0], wgp, ED); load_wfrag(ru[0], wup, ED);
        load_wfrag(rg[1], wgp + 16 * ED, ED); load_wfrag(ru[1], wup + 16 * ED, ED);
        __syncthreads();
        int cur = 0;
#pragma unroll 1
        for (int kc = 0; kc < 16; ++kc) {
            if (kc + 1 < 16) { st0 = *(const bf16x8*)(arow + 64 * (kc + 1)); st1 = *(const bf16x8*)(arow + 64 * (kc + 1) + 8); }
            const LAS char* ab = lds + L4_ABUF + cur * (128 * EAP) + l31 * EAP + 16 * h;
#pragma unroll
            for (int s = 0; s < 4; ++s) {
                const int ks = 4 * kc + s;
                const bf16x8 fg = cvt8(rg[s & 1]), fu = cvt8(ru[s & 1]);
                if (ks + 2 < 64) { load_wfrag(rg[s & 1], wgp + (size_t)(ks + 2) * 16 * ED, ED); load_wfrag(ru[s & 1], wup + (size_t)(ks + 2) * 16 * ED, ED); }
#pragma unroll
                for (int rt = 0; rt < 4; ++rt) {
                    const bf16x8 bt = *(const LAS bf16x8*)(ab + rt * 32 * EAP + 32 * s);
                    ag[rt] = MFMA32(fg, bt, ag[rt]); au[rt] = MFMA32(fu, bt, au[rt]);
                }
            }
            if (kc + 1 < 16) {
                *(LAS bf16x8*)(lds + L4_ABUF + (cur ^ 1) * (128 * EAP) + srow * EAP + 32 * spart) = st0;
                *(LAS bf16x8*)(lds + L4_ABUF + (cur ^ 1) * (128 * EAP) + srow * EAP + 32 * spart + 16) = st1;
            }
            __syncthreads();
            cur ^= 1;
        }
#pragma unroll
        for (int rt = 0; rt < 4; ++rt)
#pragma unroll
            for (int g4 = 0; g4 < 4; ++g4) {
                float a[4];
#pragma unroll
                for (int e2 = 0; e2 < 4; ++e2) a[e2] = silu_f(ag[rt][4 * g4 + e2]) * au[rt][4 * g4 + e2];
                *(LAS bf16x4*)(lds + L4_ACT + (32 * rt + l31) * ACTP + (32 * wv + 8 * g4 + 4 * h) * 2) = pack4(a[0], a[1], a[2], a[3]);
            }
        __syncthreads();
        float gq[4]; int aq[4];
#pragma unroll
        for (int rt = 0; rt < 4; ++rt) { aq[rt] = rowasg[32 * rt + l31]; gq[rt] = gatebuf[aq[rt]]; }
#pragma unroll 1
        for (int rd = 0; rd < 2; ++rd) {
            f32x16 ya[2][4];
#pragma unroll
            for (int i = 0; i < 2; ++i)
#pragma unroll
                for (int rt = 0; rt < 4; ++rt)
#pragma unroll
                    for (int r = 0; r < 16; ++r) ya[i][rt][r] = 0.f;
            const int n0 = 128 * wv + 64 * rd;
            const float* wdp = p.w_down_e + (size_t)e * ED * DM + (size_t)(8 * h) * DM + n0 + l31;
            float r0[2][8], r1[2][8];
            load_wfrag(r0[0], wdp, DM); load_wfrag(r1[0], wdp + 32, DM);
            load_wfrag(r0[1], wdp + (size_t)16 * DM, DM); load_wfrag(r1[1], wdp + (size_t)16 * DM + 32, DM);
            const LAS char* ab = lds + L4_ACT + l31 * ACTP + 16 * h;
#pragma unroll 2
            for (int ks = 0; ks < 16; ++ks) {
                const bf16x8 f0 = cvt8(r0[ks & 1]), f1 = cvt8(r1[ks & 1]);
                if (ks + 2 < 16) { load_wfrag(r0[ks & 1], wdp + (size_t)(ks + 2) * 16 * DM, DM); load_wfrag(r1[ks & 1], wdp + (size_t)(ks + 2) * 16 * DM + 32, DM); }
#pragma unroll
                for (int rt = 0; rt < 4; ++rt) {
                    const bf16x8 bt = *(const LAS bf16x8*)(ab + rt * 32 * ACTP + 32 * ks);
                    ya[0][rt] = MFMA32(f0, bt, ya[0][rt]); ya[1][rt] = MFMA32(f1, bt, ya[1][rt]);
                }
            }
#pragma unroll
            for (int rt = 0; rt < 4; ++rt) {
                if (32 * rt + l31 < nrows) {
                    bf16* yr = ybuf + (size_t)aq[rt] * DM + n0 + 4 * h;
#pragma unroll
                    for (int i = 0; i < 2; ++i)
#pragma unroll
                        for (int g4 = 0; g4 < 4; ++g4)
                            *(bf16x4*)(yr + 32 * i + 8 * g4) = pack4(ya[i][rt][4 * g4] * gq[rt], ya[i][rt][4 * g4 + 1] * gq[rt], ya[i][rt][4 * g4 + 2] * gq[rt], ya[i][rt][4 * g4 + 3] * gq[rt]);
                }
            }
        }
        __syncthreads();
    }
}

DI void phase5(const Params& p, int vcu, int G, int wid) {
    const bf16* ybuf = (const bf16*)(p.ws + WS_Y);
    const int gtid = vcu * NTHR + tid_of(wid), gth = G * NTHR;
    for (int i = gtid; i < NTOK * (DM / 8); i += gth) {
        const int tok = i >> 7, n = (i & 127) * 8, b = tok / SEQ;
        float s[8];
#pragma unroll
        for (int e = 0; e < 8; ++e) s[e] = 0.f;
#pragma unroll
        for (int k = 0; k < 8; ++k) {
            const bf16x8 v = *(const bf16x8*)(ybuf + ((size_t)tok * 8 + k) * DM + n);
#pragma unroll
            for (int e = 0; e < 8; ++e) s[e] += (float)v[e];
        }
        float* op = p.out + (size_t)tok * DM + n;
        f32x4 o0 = *(f32x4*)op, o1 = *(f32x4*)(op + 4);
        const float* gm = (const float*)(p.ws + WS_MODF) + b * 6144 + 5 * DM + n;
        const f32x4 g0 = *(const f32x4*)gm, g1 = *(const f32x4*)(gm + 4);
#pragma unroll
        for (int e = 0; e < 4; ++e) { o0[e] += g0[e] * s[e]; o1[e] += g1[e] * s[4 + e]; }
        *(f32x4*)op = o0; *(f32x4*)(op + 4) = o1;
    }
}

DI int vcu_of(int bx, int G) { return (G % 8 == 0) ? (bx % 8) * (G / 8) + bx / 8 : bx; }
#if FUSED
__global__ void __launch_bounds__(NTHR) mk_fwd(Params p) {
    extern __shared__ __attribute__((aligned(16))) unsigned char lds_raw[];
    LAS char* lds = (LAS char*)lds_raw;
    const int G = gridDim.x, vcu = vcu_of(blockIdx.x, G);
    const int wid = __builtin_amdgcn_readfirstlane((int)threadIdx.x >> 6);
    volatile LAS unsigned* st = (volatile LAS unsigned*)(lds + LDS_BARW);
    if (tid_of(wid) == 0) { st[0] = 0u; st[1] = 0u; }
    __syncthreads();
    XcdBarrier bar = xcd_barrier_post((unsigned*)(p.ws + WS_CTL), st, wid);
    phase0(p, lds, vcu, G, wid);
    xcd_barrier(bar);
    phase1(p, lds, vcu, wid);
    xcd_barrier(bar);
    phase2(p, lds, vcu, G, wid);
    xcd_barrier(bar);
    phase3(p, lds, vcu, wid);
    xcd_barrier(bar);
    phase4(p, lds, vcu, G, wid);
    xcd_barrier(bar);
    phase5(p, vcu, G, wid);
}
#else
#define LDSDECL extern __shared__ __attribute__((aligned(16))) unsigned char lds_raw[]; LAS char* lds = (LAS char*)lds_raw; const int G = gridDim.x, vcu = vcu_of(blockIdx.x, G); const int wid = __builtin_amdgcn_readfirstlane((int)threadIdx.x >> 6); (void)lds; (void)vcu;
__global__ void __launch_bounds__(NTHR) k_p0(Params p) { LDSDECL phase0(p, lds, vcu, G, wid); }
__global__ void __launch_bounds__(NTHR) k_p1(Params p) { LDSDECL phase1(p, lds, vcu, wid); }
__global__ void __launch_bounds__(NTHR) k_p2(Params p) { LDSDECL phase2(p, lds, vcu, G, wid); }
__global__ void __launch_bounds__(NTHR) k_p3(Params p) { LDSDECL phase3(p, lds, vcu, wid); }
__global__ void __launch_bounds__(NTHR) k_p4(Params p) { LDSDECL phase4(p, lds, vcu, G, wid); }
__global__ void __launch_bounds__(NTHR) k_p5(Params p) { LDSDECL phase5(p, vcu, G, wid); }
#endif

extern "C" void kernel_launch(void* const* d_in, const int* in_sizes, int n_in, void* d_out, int out_size, void* d_ws, size_t ws_size, hipStream_t stream) {
    if (n_in != 24 || ws_size < WS_END) { fprintf(stderr, "kernel_launch: unexpected inputs (n_in %d, ws %zu < %zu)\n", n_in, ws_size, (size_t)WS_END); return; }
    Params p{};
    p.x = (const float*)d_in[0]; p.c = (const float*)d_in[1]; p.pos = (const int*)d_in[2];
    p.w_ada = (const float*)d_in[3]; p.b_ada = (const float*)d_in[4]; p.g_mix = (const float*)d_in[5]; p.w_in = (const float*)d_in[6];
    p.g_q_a = (const float*)d_in[7]; p.g_k_a = (const float*)d_in[8]; p.sinks = (const float*)d_in[9]; p.g_q_b = (const float*)d_in[10]; p.g_k_b = (const float*)d_in[11];
    p.g_out_a = (const float*)d_in[12]; p.g_out_b = (const float*)d_in[13]; p.w_out = (const float*)d_in[14]; p.g_ffn = (const float*)d_in[15];
    p.w_router = (const float*)d_in[16]; p.r_bias = (const float*)d_in[17]; p.w_gate_e = (const float*)d_in[18]; p.w_up_e = (const float*)d_in[19]; p.w_down_e = (const float*)d_in[20];
    p.w_gate_s = (const float*)d_in[21]; p.w_up_s = (const float*)d_in[22]; p.w_down_s = (const float*)d_in[23];
    p.out = (float*)d_out; p.ws = (unsigned char*)d_ws;
    hipMemsetAsync((char*)d_ws + WS_CTL, 0, CTL_BYTES, stream);
    const int G = 256;
#if FUSED
    static bool attr_done = false;
    if (!attr_done) { hipFuncSetAttribute((const void*)mk_fwd, hipFuncAttributeMaxDynamicSharedMemorySize, LDS_BYTES); attr_done = true; }
    void* args[] = { &p };
    hipError_t e = hipLaunchCooperativeKernel((const void*)mk_fwd, dim3(G), dim3(NTHR), args, LDS_BYTES, stream);
    if (e != hipSuccess) fprintf(stderr, "cooperative launch failed: %s\n", hipGetErrorString(e));
#else
    static bool attr_done = false;
    if (!attr_done) {
        hipFuncSetAttribute((const void*)k_p0, hipFuncAttributeMaxDynamicSharedMemorySize, LDS_BYTES);
        hipFuncSetAttribute((const void*)k_p1, hipFuncAttributeMaxDynamicSharedMemorySize, LDS_BYTES);
        hipFuncSetAttribute((const void*)k_p2, hipFuncAttributeMaxDynamicSharedMemorySize, LDS_BYTES);
        hipFuncSetAttribute((const void*)k_p3, hipFuncAttributeMaxDynamicSharedMemorySize, LDS_BYTES);
        hipFuncSetAttribute((const void*)k_p4, hipFuncAttributeMaxDynamicSharedMemorySize, LDS_BYTES);
        hipFuncSetAttribute((const void*)k_p5, hipFuncAttributeMaxDynamicSharedMemorySize, LDS_BYTES);
        attr_done = true;
    }
    hipLaunchKernelGGL(k_p0, dim3(G), dim3(NTHR), LDS_BYTES, stream, p);
    hipLaunchKernelGGL(k_p1, dim3(G), dim3(NTHR), LDS_BYTES, stream, p);
    hipLaunchKernelGGL(k_p2, dim3(G), dim3(NTHR), LDS_BYTES, stream, p);
    hipLaunchKernelGGL(k_p3, dim3(G), dim3(NTHR), LDS_BYTES, stream, p);
    hipLaunchKernelGGL(k_p4, dim3(G), dim3(NTHR), LDS_BYTES, stream, p);
    hipLaunchKernelGGL(k_p5, dim3(G), dim3(NTHR), LDS_BYTES, stream, p);
#endif
}
```

```cpp
#include <hip/hip_runtime.h>
#include <stdint.h>
#include <cstdio>

#ifndef FUSED
#define FUSED 1
#endif
#ifndef REP
#define REP -1
#endif

typedef __bf16 bf16;
typedef __attribute__((ext_vector_type(8))) __bf16 bf16x8;
typedef __attribute__((ext_vector_type(4))) __bf16 bf16x4;
typedef __attribute__((ext_vector_type(16))) float f32x16;
typedef __attribute__((ext_vector_type(4))) float f32x4;
typedef __attribute__((ext_vector_type(4))) short s16x4;
typedef __attribute__((ext_vector_type(8))) short s16x8;
#define LAS __attribute__((address_space(3)))
#define DI __device__ __forceinline__
#define MFMA32(a, b, c) __builtin_amdgcn_mfma_f32_32x32x16_bf16((a), (b), (c), 0, 0, 0)

constexpr int NB = 8, SEQ = 2048, DM = 1024, NTOK = NB * SEQ, INW = 2304;
constexpr int KA_OFF = 512, VA_OFF = 640, QB_OFF = 768, KB_OFF = 1280, VB_OFF = 1792;
constexpr int NE = 256, ED = 256, LCAP = NTOK;
constexpr float EPS = 1e-6f;
constexpr int NTHR = 512, NWAVE = 8;
constexpr int PITCH = 2064;
constexpr int LDS_BYTES = 155648;
constexpr int LDS_MISC = 64 * PITCH;
constexpr int LDS_BARW = LDS_BYTES - 16;

constexpr size_t WS_CTL = 0;
constexpr size_t CTL_BYTES = 65536;
constexpr size_t CTL_CNT = 32768;
constexpr size_t CTL_Q = 40960;
constexpr size_t WS_MODP = WS_CTL + CTL_BYTES;
constexpr size_t WS_MODF = WS_MODP + 8ull * 8 * 6144 * 4;
constexpr size_t WS_ROPE = WS_MODF + 8ull * 6144 * 4;
constexpr size_t WS_WIN = WS_ROPE + 2ull * NTOK * 8 * 4;
constexpr size_t WS_WOUT = WS_WIN + (size_t)INW * DM * 2;
constexpr size_t WS_WR = WS_WOUT + (size_t)DM * DM * 2;
constexpr size_t WS_WGS = WS_WR + (size_t)NE * DM * 2;
constexpr size_t WS_WUS = WS_WGS + (size_t)256 * DM * 2;
constexpr size_t WS_WDS = WS_WUS + (size_t)256 * DM * 2;
constexpr size_t WS_QKV = WS_WDS + (size_t)256 * DM * 2;
constexpr size_t WS_OA = WS_QKV + (size_t)NTOK * INW * 2;
constexpr size_t WS_OB = WS_OA + (size_t)NTOK * 512 * 2;
constexpr size_t WS_LSE = WS_OB + 3ull * NTOK * 512 * 2;
constexpr size_t WS_H2 = WS_LSE + 3ull * NTOK * 8 * 4;
constexpr size_t WS_LOG = WS_H2 + (size_t)NTOK * DM * 2;
constexpr size_t WS_GATE = WS_LOG + (size_t)NTOK * NE * 4;
constexpr size_t WS_LIST = WS_GATE + (size_t)NTOK * 8 * 4;
constexpr size_t WS_Y = WS_LIST + (size_t)NE * LCAP * 4;
constexpr size_t WS_SG = WS_Y + (size_t)NTOK * 8 * DM * 2;
constexpr size_t WS_END = WS_SG + 256ull * 8 * 16 * 64 * 16;

struct Params {
    const float *x, *c; const int* pos;
    const float *w_ada, *b_ada, *g_mix, *w_in, *g_q_a, *g_k_a, *sinks, *g_q_b, *g_k_b, *g_out_a, *g_out_b, *w_out, *g_ffn, *w_router, *r_bias;
    const float *w_gate_e, *w_up_e, *w_down_e, *w_gate_s, *w_up_s, *w_down_s;
    float* out; unsigned char* ws;
};

DI float shx(float v, int mask, int lane) { return __builtin_bit_cast(float, __builtin_amdgcn_ds_bpermute((lane ^ mask) << 2, __builtin_bit_cast(int, v))); }
DI int shxi(int v, int mask, int lane) { return __builtin_amdgcn_ds_bpermute((lane ^ mask) << 2, v); }
DI float shidx(float v, int src, int lane) { (void)lane; return __builtin_bit_cast(float, __builtin_amdgcn_ds_bpermute(src << 2, __builtin_bit_cast(int, v))); }
DI float wave_sum(float v, int lane) {
#pragma unroll
    for (int o = 1; o < 64; o <<= 1) v += shx(v, o, lane);
    return v;
}
DI int lane_opaque() { int l = (int)__builtin_amdgcn_mbcnt_hi(~0u, __builtin_amdgcn_mbcnt_lo(~0u, 0u)); asm volatile("" : "+v"(l)); return l; }
DI int wid_opaque(int wid) { int w = wid; asm volatile("" : "+s"(w)); return w; }
DI int tid_of(int wid) { return wid_opaque(wid) * 64 + lane_opaque(); }
DI int crow(int r, int h) { return (r & 3) + 8 * (r >> 2) + 4 * h; }
DI float silu_f(float v) { return v * __builtin_amdgcn_rcpf(1.f + __expf(-v)); }
DI float mod_val(const Params& p, int b, int idx) {
    const float* mp = (const float*)(p.ws + WS_MODP);
    float s = p.b_ada[idx];
#pragma unroll
    for (int ks = 0; ks < 8; ++ks) s += mp[(size_t)(ks * 8 + b) * 6144 + idx];
    return s;
}
DI bf16x4 pack4(float a, float b, float c, float d) { bf16x4 v; v[0] = (bf16)a; v[1] = (bf16)b; v[2] = (bf16)c; v[3] = (bf16)d; return v; }

#define XB_TMO      128
#define XB_XCNT(j)  (256  + 64 * (j))
#define XB_XSUB(j)  (1280 + 64 * (j))
#define XB_XGEN(j)  (2304 + 64 * (j))
#define XB_TOP      3328
#define XB_TOPGEN   3392
#define XCD_BAR_WORDS 3456
#define XB_SPIN_CAP (1u << 22)
DI unsigned xb_ld(unsigned* p) { return __hip_atomic_load(p, __ATOMIC_RELAXED, __HIP_MEMORY_SCOPE_AGENT); }
DI unsigned xb_add(unsigned* p, unsigned v) { return __hip_atomic_fetch_add(p, v, __ATOMIC_RELAXED, __HIP_MEMORY_SCOPE_AGENT); }
DI unsigned xb_xcc_id() { return (unsigned)__builtin_amdgcn_s_getreg((3 << 11) | 20) & 0xFu; }
#define XB_SPIN(cond, bar) do { unsigned _sp = 0; while (cond) { __builtin_amdgcn_s_sleep(1); \
    if ((++_sp & 255u) == 0u) { if (xb_ld(&(bar)[XB_TMO])) break; if (_sp > XB_SPIN_CAP) { atomicAdd(&(bar)[XB_TMO], 1u); break; } } } } while (0)
struct XcdBarrier { unsigned* bar; unsigned x; volatile LAS unsigned* st; int wid; };
DI XcdBarrier xcd_barrier_post(unsigned* bar, volatile LAS unsigned* st, int wid) {
    XcdBarrier b; b.bar = bar; b.x = xb_xcc_id(); b.st = st; b.wid = wid;
    if (tid_of(wid) == 0) (void)xb_add(&bar[XB_XCNT(b.x)], 1u);
    return b;
}
DI void xcd_barrier_complete(unsigned* bar, unsigned x, unsigned& nloc, unsigned& nx) {
    const unsigned G = gridDim.x * gridDim.y * gridDim.z;
    unsigned sum, cnt, mine, sp = 0u;
    for (;;) {
        sum = 0u; cnt = 0u; mine = 0u;
#pragma unroll
        for (unsigned j = 0; j < 16; ++j) { const unsigned c = xb_ld(&bar[XB_XCNT(j)]); sum += c; cnt += (c > 0u) ? 1u : 0u; mine = (j == x) ? c : mine; }
        if (sum == G) break;
        __builtin_amdgcn_s_sleep(1);
        if ((++sp & 255u) == 0u) { if (xb_ld(&bar[XB_TMO])) break; if (sp > XB_SPIN_CAP) { atomicAdd(&bar[XB_TMO], 1u); break; } }
    }
    nloc = mine > 0u ? mine : 1u; nx = cnt > 0u ? cnt : 1u;
}
DI void xcd_barrier(const XcdBarrier& b) {
    asm volatile("s_waitcnt vmcnt(0)" ::: "memory");
    __syncthreads();
    if (tid_of(b.wid) == 0) {
        unsigned* bar = b.bar;
        __builtin_amdgcn_s_waitcnt(0);
        unsigned nloc = b.st[0], nx = b.st[1];
        if (nloc == 0u) { xcd_barrier_complete(bar, b.x, nloc, nx); b.st[0] = nloc; b.st[1] = nx; }
        const unsigned old = xb_add(&bar[XB_XSUB(b.x)], 1u);
        const unsigned gen = old / nloc;
        if (old + 1u == (gen + 1u) * nloc) {
            __builtin_amdgcn_fence(__ATOMIC_RELEASE, "agent");
            asm volatile("s_waitcnt vmcnt(0)" ::: "memory");
            const unsigned og = xb_add(&bar[XB_TOP], 1u);
            const unsigned tg = og / nx;
            if (og + 1u == (tg + 1u) * nx) xb_add(&bar[XB_TOPGEN], 1u);
            else XB_SPIN(xb_ld(&bar[XB_TOPGEN]) == tg, bar);
            __builtin_amdgcn_fence(__ATOMIC_ACQUIRE, "agent");
            xb_add(&bar[XB_XGEN(b.x)], 1u);
            asm volatile("s_waitcnt vmcnt(0)" ::: "memory");
        } else {
            XB_SPIN(xb_ld(&bar[XB_XGEN(b.x)]) == gen, bar);
            __builtin_amdgcn_fence(__ATOMIC_ACQUIRE, "agent");
            asm volatile("s_waitcnt vmcnt(0)" ::: "memory");
        }
    }
    __syncthreads();
}

template <int NT, int KS>
DI void gemm_ct(f32x16 (&acc)[NT][2], const bf16x8* const (&wp)[NT], const LAS char* panel, int pitch, int lane) {
    const LAS char* b0 = panel + (lane & 31) * pitch + (lane >> 5) * 16;
    const LAS char* b1 = b0 + 32 * pitch;
    constexpr int PF = (NT >= 4) ? 2 : 4;
    bf16x8 w[PF][NT];
#pragma unroll
    for (int q = 0; q < PF; ++q)
#pragma unroll
        for (int i = 0; i < NT; ++i) w[q][i] = wp[i][q * 64];
#pragma unroll 1
    for (int ks0 = 0; ks0 < KS; ks0 += PF) {
#pragma unroll
        for (int q = 0; q < PF; ++q) {
            const int ks = ks0 + q;
            bf16x8 a[NT];
#pragma unroll
            for (int i = 0; i < NT; ++i) a[i] = w[q][i];
#pragma unroll
            for (int i = 0; i < NT; ++i) w[q][i] = wp[i][((ks + PF) & (KS - 1)) * 64];
            const bf16x8 t0 = *(const LAS bf16x8*)(b0 + ks * 32);
            const bf16x8 t1 = *(const LAS bf16x8*)(b1 + ks * 32);
#pragma unroll
            for (int i = 0; i < NT; ++i) { acc[i][0] = MFMA32(a[i], t0, acc[i][0]); acc[i][1] = MFMA32(a[i], t1, acc[i][1]); }
            __builtin_amdgcn_sched_barrier(0);
        }
    }
}
template <int NT> DI void zero_acc(f32x16 (&acc)[NT][2]) {
#pragma unroll
    for (int i = 0; i < NT; ++i)
#pragma unroll
        for (int t = 0; t < 2; ++t)
#pragma unroll
            for (int r = 0; r < 16; ++r) acc[i][t][r] = 0.f;
}

DI void convert_sw(const float* W, int K, int N, bf16x8* dst, const float* sa, const float* sb, int gtid, int gthreads) {
    const int KS = K / 16, total = (N / 32) * KS * 64;
    for (int pc = gtid; pc < total; pc += gthreads) {
        const int l = pc & 63, ks = (pc >> 6) % KS, nt = (pc >> 6) / KS;
        const int n = 32 * nt + (l & 31), k0 = 16 * ks + 8 * (l >> 5);
        bf16x8 v;
#pragma unroll
        for (int j = 0; j < 8; ++j) {
            float w = W[(size_t)(k0 + j) * N + n];
            if (sa) { const int k = k0 + j; w *= (k < 512) ? sa[k] : sb[k - 512]; }
            v[j] = (bf16)w;
        }
        dst[pc] = v;
    }
}
DI void phase0(const Params& p, LAS char* lds, int vcu, int G, int wid) {
    const int lane = lane_opaque(), wv = wid_opaque(wid), tid = wv * 64 + lane;
    LAS float* red = (LAS float*)lds;
    for (int it = vcu; it < 96 * 8; it += G) {
        const int cc = it % 96, ks = it / 96;
        float acc[8];
#pragma unroll
        for (int b = 0; b < 8; ++b) acc[b] = 0.f;
        const int n = 64 * cc + lane;
        for (int i = 0; i < 16; ++i) {
            const int k = 128 * ks + 16 * wv + i;
            const float w = p.w_ada[(size_t)k * 6144 + n];
#pragma unroll
            for (int b = 0; b < 8; ++b) acc[b] += silu_f(p.c[b * DM + k]) * w;
        }
#pragma unroll
        for (int b = 0; b < 8; ++b) red[(wv * 8 + b) * 64 + lane] = acc[b];
        __syncthreads();
        {
            const int b = tid >> 6, col = tid & 63;
            float s = 0.f;
#pragma unroll
            for (int w8 = 0; w8 < 8; ++w8) s += red[(w8 * 8 + b) * 64 + col];
            ((float*)(p.ws + WS_MODP))[(size_t)(ks * 8 + b) * 6144 + 64 * cc + col] = s;
        }
        __syncthreads();
    }
    const int gtid = vcu * NTHR + tid, gth = G * NTHR;
    convert_sw(p.w_in, DM, INW, (bf16x8*)(p.ws + WS_WIN), nullptr, nullptr, gtid, gth);
    convert_sw(p.w_out, DM, DM, (bf16x8*)(p.ws + WS_WOUT), p.g_out_a, p.g_out_b, gtid, gth);
    convert_sw(p.w_router, DM, NE, (bf16x8*)(p.ws + WS_WR), nullptr, nullptr, gtid, gth);
    convert_sw(p.w_gate_s, DM, 256, (bf16x8*)(p.ws + WS_WGS), nullptr, nullptr, gtid, gth);
    convert_sw(p.w_up_s, DM, 256, (bf16x8*)(p.ws + WS_WUS), nullptr, nullptr, gtid, gth);
    convert_sw(p.w_down_s, 256, DM, (bf16x8*)(p.ws + WS_WDS), nullptr, nullptr, gtid, gth);
    float* cosT = (float*)(p.ws + WS_ROPE); float* sinT = cosT + (size_t)NTOK * 8;
    for (int e = gtid; e < NTOK * 8; e += gth) {
        const int t = e >> 3, i = e & 7;
        const float inv = (float)exp2(-(double)i * 0.125 * 18.931568569324174);
        const float ang = (float)p.pos[t] * inv;
        double rev = (double)ang * 0.15915494309189535; rev -= floor(rev);
        cosT[e] = __builtin_amdgcn_cosf((float)rev);
        sinT[e] = __builtin_amdgcn_sinf((float)rev);
    }
}

DI void phase1(const Params& p, LAS char* lds, int wg, int wid) {
    const int lane = lane_opaque(), wv = wid_opaque(wid), tid = wv * 64 + lane;
    const int t0 = wg * 64, b = t0 / SEQ;
    if (tid < 192) { const int idx = (wg & 31) * 192 + tid; ((float*)(p.ws + WS_MODF))[b * 6144 + idx] = mod_val(p, b, idx); }
    {
        float ga[16], sh[16];
#pragma unroll
        for (int j = 0; j < 4; ++j)
#pragma unroll
            for (int e = 0; e < 4; ++e) {
                const int k = 256 * j + 4 * lane + e;
                ga[4 * j + e] = p.g_mix[k] * (1.f + mod_val(p, b, 1 * DM + k));
                sh[4 * j + e] = mod_val(p, b, 0 * DM + k);
            }
#pragma unroll 1
        for (int i = 0; i < 8; ++i) {
            const int row = 8 * wv + i;
            const float* xr = p.x + (size_t)(t0 + row) * DM;
            f32x4 v[4]; float ss = 0.f;
#pragma unroll
            for (int j = 0; j < 4; ++j) { v[j] = *(const f32x4*)(xr + 256 * j + 4 * lane); ss += v[j][0] * v[j][0] + v[j][1] * v[j][1] + v[j][2] * v[j][2] + v[j][3] * v[j][3]; }
            const float rstd = rsqrtf(wave_sum(ss, lane) * (1.f / DM) + EPS);
#pragma unroll
            for (int j = 0; j < 4; ++j) {
                const bf16x4 o = pack4(v[j][0] * rstd * ga[4 * j] + sh[4 * j], v[j][1] * rstd * ga[4 * j + 1] + sh[4 * j + 1],
                                       v[j][2] * rstd * ga[4 * j + 2] + sh[4 * j + 2], v[j][3] * rstd * ga[4 * j + 3] + sh[4 * j + 3]);
                *(LAS bf16x4*)(lds + row * PITCH + (256 * j + 4 * lane) * 2) = o;
            }
        }
    }
    __syncthreads();
    const bf16x8* wsw = (const bf16x8*)(p.ws + WS_WIN);
    const float* cosT = (const float*)(p.ws + WS_ROPE); const float* sinT = cosT + (size_t)NTOK * 8;
    bf16* qkv = (bf16*)(p.ws + WS_QKV);
    const int h = lane >> 5;
#pragma unroll 1
    for (int u = wv; u < 36; u += NWAVE) {
        f32x16 acc[2][2]; zero_acc<2>(acc);
        const bf16x8* wp[2] = { wsw + (size_t)(2 * u) * 64 * 64 + lane, wsw + (size_t)(2 * u + 1) * 64 * 64 + lane };
        gemm_ct<2, 64>(acc, wp, lds, PITCH, lane);
        const float* g = nullptr; float qs = 1.f;
        if (u < 8) { g = p.g_q_a; qs = 0.125f; } else if (u < 10) g = p.g_k_a; else if (u >= 12 && u < 20) { g = p.g_q_b; qs = 0.125f; } else if (u >= 20 && u < 28) g = p.g_k_b;
#pragma unroll
        for (int tt = 0; tt < 2; ++tt) {
            const int tok = t0 + 32 * tt + (lane & 31);
            if (g) {
                float ss = 0.f;
#pragma unroll
                for (int nt = 0; nt < 2; ++nt)
#pragma unroll
                    for (int r = 0; r < 16; ++r) ss += acc[nt][tt][r] * acc[nt][tt][r];
                ss += shx(ss, 32, lane);
                const float rstd = rsqrtf(ss * (1.f / 64.f) + EPS);
#pragma unroll
                for (int nt = 0; nt < 2; ++nt)
#pragma unroll
                    for (int r = 0; r < 16; ++r) acc[nt][tt][r] *= rstd * g[32 * nt + crow(r, h)];
#pragma unroll
                for (int r = 0; r < 4; ++r) {
                    const int i = r + 4 * h;
                    const float cs = cosT[(size_t)tok * 8 + i], sn = sinT[(size_t)tok * 8 + i];
                    const float a1 = acc[0][tt][r], a2 = acc[0][tt][r + 4];
                    acc[0][tt][r] = a1 * cs - a2 * sn; acc[0][tt][r + 4] = a2 * cs + a1 * sn;
                }
            }
#pragma unroll
            for (int nt = 0; nt < 2; ++nt)
#pragma unroll
                for (int g4 = 0; g4 < 4; ++g4) {
                    const bf16x4 o = pack4(acc[nt][tt][4 * g4] * qs, acc[nt][tt][4 * g4 + 1] * qs, acc[nt][tt][4 * g4 + 2] * qs, acc[nt][tt][4 * g4 + 3] * qs);
                    *(bf16x4*)(qkv + (size_t)tok * INW + 64 * u + 32 * nt + 8 * g4 + 4 * h) = o;
                }
        }
    }
}

constexpr int VP = 192;
DI void attn_unit(const Params& p, LAS char* vimg, int u, int lane) {
    const int combo = u & 31, blk = (u >> 5) & 31, b = u >> 10;
    const int h = lane >> 5, l31 = lane & 31;
    int qoff, koff, voff, dil, maxd; float m_init, l_init; bf16* outp; float* lsep = nullptr; int hb;
    if (combo < 8) {
        hb = combo; qoff = 64 * hb; koff = KA_OFF + 64 * (hb >> 2); voff = VA_OFF + 64 * (hb >> 2); dil = 1; maxd = 127;
        m_init = p.sinks[hb]; l_init = 1.f; outp = (bf16*)(p.ws + WS_OA);
    } else {
        const int br = (combo - 8) >> 3; hb = (combo - 8) & 7;
        qoff = QB_OFF + 64 * hb; koff = KB_OFF + 64 * hb; voff = VB_OFF + 64 * hb; dil = (br == 0) ? 1 : (br == 1 ? 4 : 16); maxd = 128;
        m_init = -1e30f; l_init = 0.f; outp = (bf16*)(p.ws + WS_OB) + (size_t)br * NTOK * 512; lsep = (float*)(p.ws + WS_LSE) + (size_t)br * NTOK * 8;
    }
    const int L = SEQ / dil, nb = L / 64, rho = blk / nb, l0 = (blk % nb) * 64;
    const bf16* qkv = (const bf16*)(p.ws + WS_QKV) + (size_t)b * SEQ * INW;
    bf16x8 qf[2][4];
#pragma unroll
    for (int qt = 0; qt < 2; ++qt) {
        const bf16* qp = qkv + (size_t)((l0 + 32 * qt + l31) * dil + rho) * INW + qoff + 8 * h;
#pragma unroll
        for (int s = 0; s < 4; ++s) qf[qt][s] = *(const bf16x8*)(qp + 16 * s);
    }
    f32x16 o[2][2];
#pragma unroll
    for (int dt = 0; dt < 2; ++dt)
#pragma unroll
        for (int qt = 0; qt < 2; ++qt)
#pragma unroll
            for (int r = 0; r < 16; ++r) o[dt][qt][r] = 0.f;
    float mrun[2] = { m_init, m_init }, lrun[2] = { h == 0 ? l_init : 0.f, h == 0 ? l_init : 0.f };
    const float LOG2E = 1.4426950408889634f;
#pragma unroll 1
    for (int kt = 0; kt < 6; ++kt) {
        const int lk0 = l0 - 128 + 32 * kt;
        if (lk0 + 31 < 0) continue;
        bf16x8 kf[4];
        {
            int lk = lk0 + l31; lk = lk < 0 ? 0 : lk;
            const bf16* kp = qkv + (size_t)(lk * dil + rho) * INW + koff + 8 * h;
#pragma unroll
            for (int s = 0; s < 4; ++s) kf[s] = *(const bf16x8*)(kp + 16 * s);
        }
        {
            bf16x8 vr[4];
#pragma unroll
            for (int i = 0; i < 4; ++i) {
                int lk = lk0 + (lane >> 3) + 8 * i; lk = lk < 0 ? 0 : lk;
                vr[i] = *(const bf16x8*)(qkv + (size_t)(lk * dil + rho) * INW + voff + 8 * (lane & 7));
            }
#pragma unroll
            for (int i = 0; i < 4; ++i) *(LAS bf16x8*)(vimg + ((lane >> 3) + 8 * i) * VP + 16 * (lane & 7)) = vr[i];
        }
        bf16x8 vf[2][2];
        {
            const int g1 = (lane >> 4) & 1, q4 = (lane & 15) >> 2, p4 = lane & 3;
#pragma unroll
            for (int dt = 0; dt < 2; ++dt)
#pragma unroll
                for (int s = 0; s < 2; ++s) {
                    const LAS char* a0 = vimg + (16 * s + 4 * h + q4) * VP + (32 * dt + 16 * g1 + 4 * p4) * 2;
                    const s16x4 lo = __builtin_amdgcn_ds_read_tr16_b64_v4i16((LAS s16x4*)a0);
                    const s16x4 hi = __builtin_amdgcn_ds_read_tr16_b64_v4i16((LAS s16x4*)(a0 + 8 * VP));
                    const s16x8 c = __builtin_shufflevector(lo, hi, 0, 1, 2, 3, 4, 5, 6, 7);
                    vf[dt][s] = __builtin_bit_cast(bf16x8, c);
                }
        }
#pragma unroll
        for (int qt = 0; qt < 2; ++qt) {
            if ((qt == 0 && kt == 5) || (qt == 1 && kt == 0)) continue;
            f32x16 sacc;
#pragma unroll
            for (int r = 0; r < 16; ++r) sacc[r] = 0.f;
#pragma unroll
            for (int s = 0; s < 4; ++s) sacc = MFMA32(kf[s], qf[qt][s], sacc);
            const int lq = l0 + 32 * qt + l31;
            float mx = -1e30f;
#pragma unroll
            for (int r = 0; r < 16; ++r) {
                const int lk = lk0 + crow(r, h), d = lq - lk;
                const bool ok = (lk >= 0) && (d >= 0) && (d <= maxd);
                sacc[r] = ok ? sacc[r] : -1e30f;
                mx = fmaxf(mx, sacc[r]);
            }
            mx = fmaxf(mx, shx(mx, 32, lane));
            const float mnew = fmaxf(mrun[qt], mx);
            const float alpha = exp2f((mrun[qt] - mnew) * LOG2E);
            float ps = 0.f;
#pragma unroll
            for (int r = 0; r < 16; ++r) { sacc[r] = exp2f((sacc[r] - mnew) * LOG2E); ps += sacc[r]; }
            lrun[qt] = lrun[qt] * alpha + ps; mrun[qt] = mnew;
#pragma unroll
            for (int dt = 0; dt < 2; ++dt)
#pragma unroll
                for (int r = 0; r < 16; ++r) o[dt][qt][r] *= alpha;
            bf16x8 pf[2];
#pragma unroll
            for (int s = 0; s < 2; ++s)
#pragma unroll
                for (int j = 0; j < 8; ++j) pf[s][j] = (bf16)sacc[8 * s + j];
#pragma unroll
            for (int dt = 0; dt < 2; ++dt)
#pragma unroll
                for (int s = 0; s < 2; ++s) o[dt][qt] = MFMA32(vf[dt][s], pf[s], o[dt][qt]);
        }
    }
#pragma unroll
    for (int qt = 0; qt < 2; ++qt) {
        const float lt = lrun[qt] + shx(lrun[qt], 32, lane);
        const float inv = 1.f / lt;
        const size_t tok = (size_t)b * SEQ + (size_t)(l0 + 32 * qt + l31) * dil + rho;
#pragma unroll
        for (int dt = 0; dt < 2; ++dt)
#pragma unroll
            for (int g4 = 0; g4 < 4; ++g4) {
                const bf16x4 v = pack4(o[dt][qt][4 * g4] * inv, o[dt][qt][4 * g4 + 1] * inv, o[dt][qt][4 * g4 + 2] * inv, o[dt][qt][4 * g4 + 3] * inv);
                *(bf16x4*)(outp + tok * 512 + 64 * hb + 32 * dt + 8 * g4 + 4 * h) = v;
            }
        if (lsep && h == 0) lsep[tok * 8 + hb] = mrun[qt] + logf(lt);
    }
}
DI void phase2(const Params& p, LAS char* lds, int vcu, int G, int wid) {
    const int lane = lane_opaque(), wv = wid_opaque(wid), tid = wv * 64 + lane;
    LAS char* vimg = lds + wv * (32 * VP);
    for (int u = vcu * NWAVE + wv; u < 8192; u += G * NWAVE) attn_unit(p, vimg, u, lane);
}

DI void phase3(const Params& p, LAS char* lds, int wg, int wid) {
    const int lane = lane_opaque(), wv = wid_opaque(wid), tid = wv * 64 + lane, h = lane >> 5, l31 = lane & 31;
    const int t0 = wg * 64, b = t0 / SEQ;
    LAS float* ga_l = (LAS float*)(lds + LDS_MISC + 2048);
    LAS float* hs_l = ga_l + 1024;
    LAS float* sh_l = hs_l + 1024;
    LAS float* gm_l = sh_l + 1024;
    {
        const float* mf = (const float*)(p.ws + WS_MODF) + b * 6144;
        for (int n = tid; n < DM; n += NTHR) { ga_l[n] = mf[2 * DM + n]; hs_l[n] = p.g_ffn[n] * (1.f + mf[4 * DM + n]); sh_l[n] = mf[3 * DM + n]; gm_l[n] = mf[5 * DM + n]; }
    }
    {
        const bf16* oa = (const bf16*)(p.ws + WS_OA); const bf16* ob = (const bf16*)(p.ws + WS_OB); const float* lse = (const float*)(p.ws + WS_LSE);
#pragma unroll 1
        for (int i = 0; i < 8; ++i) {
            const int row = 8 * wv + i; const size_t tok = t0 + row;
            float v[16];
            if (h == 0) {
                const bf16x8 a0 = *(const bf16x8*)(oa + tok * 512 + 16 * l31), a1 = *(const bf16x8*)(oa + tok * 512 + 16 * l31 + 8);
#pragma unroll
                for (int j = 0; j < 8; ++j) { v[j] = (float)a0[j]; v[8 + j] = (float)a1[j]; }
            } else {
                const int hd = l31 >> 2;
                const float e0 = lse[tok * 8 + hd], e1 = lse[(size_t)NTOK * 8 + tok * 8 + hd], e2 = lse[(size_t)2 * NTOK * 8 + tok * 8 + hd];
                const float mx = fmaxf(e0, fmaxf(e1, e2));
                float w0 = __expf(e0 - mx), w1 = __expf(e1 - mx), w2 = __expf(e2 - mx);
                const float wi = 1.f / (w0 + w1 + w2); w0 *= wi; w1 *= wi; w2 *= wi;
#pragma unroll
                for (int j = 0; j < 16; ++j) v[j] = 0.f;
#pragma unroll
                for (int br = 0; br < 3; ++br) {
                    const bf16* src = ob + (size_t)br * NTOK * 512 + tok * 512 + 16 * l31;
                    const bf16x8 a0 = *(const bf16x8*)src, a1 = *(const bf16x8*)(src + 8);
                    const float w = br == 0 ? w0 : (br == 1 ? w1 : w2);
#pragma unroll
                    for (int j = 0; j < 8; ++j) { v[j] += w * (float)a0[j]; v[8 + j] += w * (float)a1[j]; }
                }
            }
            float ss = 0.f;
#pragma unroll
            for (int j = 0; j < 16; ++j) ss += v[j] * v[j];
#pragma unroll
            for (int o2 = 1; o2 < 32; o2 <<= 1) ss += shx(ss, o2, lane);
            const float rstd = rsqrtf(ss * (1.f / 512.f) + EPS);
            bf16x8 o0, o1;
#pragma unroll
            for (int j = 0; j < 8; ++j) { o0[j] = (bf16)(v[j] * rstd); o1[j] = (bf16)(v[8 + j] * rstd); }
            LAS char* dst = lds + row * PITCH + (512 * h + 16 * l31) * 2;
            *(LAS bf16x8*)dst = o0; *(LAS bf16x8*)(dst + 16) = o1;
        }
    }
    __syncthreads();
    f32x16 x1[4][2]; zero_acc<4>(x1);
    {
        const bf16x8* wsw = (const bf16x8*)(p.ws + WS_WOUT);
        const bf16x8* wp[4];
#pragma unroll
        for (int i = 0; i < 4; ++i) wp[i] = wsw + (size_t)(4 * wv + i) * 64 * 64 + lane;
        gemm_ct<4, 64>(x1, wp, lds, PITCH, lane);
    }
    LAS float* ssx = (LAS float*)(lds + LDS_MISC);
#pragma unroll
    for (int tt = 0; tt < 2; ++tt) {
        const size_t tok = t0 + 32 * tt + l31;
        float ss = 0.f;
#pragma unroll
        for (int i = 0; i < 4; ++i)
#pragma unroll
            for (int g4 = 0; g4 < 4; ++g4) {
                const int n = 128 * wv + 32 * i + 8 * g4 + 4 * h;
                const f32x4 xv = *(const f32x4*)(p.x + tok * DM + n);
                f32x4 ov;
#pragma unroll
                for (int e = 0; e < 4; ++e) {
                    const float v = xv[e] + ga_l[n + e] * x1[i][tt][4 * g4 + e];
                    x1[i][tt][4 * g4 + e] = v; ov[e] = v; ss += v * v;
                }
                *(f32x4*)(p.out + tok * DM + n) = ov;
                __builtin_amdgcn_sched_barrier(0);
            }
        ss += shx(ss, 32, lane);
        if (h == 0) ssx[wv * 64 + 32 * tt + l31] = ss;
    }
    __syncthreads();
    {
        bf16* h2g = (bf16*)(p.ws + WS_H2);
#pragma unroll
        for (int tt = 0; tt < 2; ++tt) {
            const int row = 32 * tt + l31; const size_t tok = t0 + row;
            float ss = 0.f;
#pragma unroll
            for (int w8 = 0; w8 < 8; ++w8) ss += ssx[w8 * 64 + row];
            const float rstd = rsqrtf(ss * (1.f / DM) + EPS);
#pragma unroll
            for (int i = 0; i < 4; ++i)
#pragma unroll
                for (int g4 = 0; g4 < 4; ++g4) {
                    const int n = 128 * wv + 32 * i + 8 * g4 + 4 * h;
                    float hv[4];
#pragma unroll
                    for (int e = 0; e < 4; ++e)
                        hv[e] = x1[i][tt][4 * g4 + e] * rstd * hs_l[n + e] + sh_l[n + e];
                    const bf16x4 o = pack4(hv[0], hv[1], hv[2], hv[3]);
                    *(LAS bf16x4*)(lds + row * PITCH + n * 2) = o;
                    *(bf16x4*)(h2g + tok * DM + n) = o;
                    __builtin_amdgcn_sched_barrier(0);
                }
        }
    }
    __syncthreads();
    float* logit = (float*)(p.ws + WS_LOG);
    {
        f32x16 ra[1][2]; zero_acc<1>(ra);
        const bf16x8* wp[1] = { (const bf16x8*)(p.ws + WS_WR) + (size_t)wv * 64 * 64 + lane };
        gemm_ct<1, 64>(ra, wp, lds, PITCH, lane);
#pragma unroll
        for (int tt = 0; tt < 2; ++tt) {
            const size_t tok = t0 + 32 * tt + l31;
#pragma unroll
            for (int g4 = 0; g4 < 4; ++g4) {
                f32x4 v = { ra[0][tt][4 * g4], ra[0][tt][4 * g4 + 1], ra[0][tt][4 * g4 + 2], ra[0][tt][4 * g4 + 3] };
                *(f32x4*)(logit + tok * NE + 32 * wv + 8 * g4 + 4 * h) = v;
            }
        }
    }
    f32x16 gu[2][2]; zero_acc<2>(gu);
    {
        const bf16x8* wp[2] = { (const bf16x8*)(p.ws + WS_WGS) + (size_t)wv * 64 * 64 + lane, (const bf16x8*)(p.ws + WS_WUS) + (size_t)wv * 64 * 64 + lane };
        gemm_ct<2, 64>(gu, wp, lds, PITCH, lane);
    }
    __syncthreads();
    constexpr int AP = 528;
#pragma unroll
    for (int tt = 0; tt < 2; ++tt)
#pragma unroll
        for (int g4 = 0; g4 < 4; ++g4) {
            float a[4];
#pragma unroll
            for (int e = 0; e < 4; ++e) a[e] = silu_f(gu[0][tt][4 * g4 + e]) * gu[1][tt][4 * g4 + e];
            *(LAS bf16x4*)(lds + (32 * tt + l31) * AP + (32 * wv + 8 * g4 + 4 * h) * 2) = pack4(a[0], a[1], a[2], a[3]);
        }
    {
        const int lane = lane_opaque(); int t0y = t0; asm volatile("" : "+s"(t0y));
        const int g = lane & 7; const size_t tok = t0y + 8 * wv + (lane >> 3);
        float bia[32], sc[32];
        const float* lp = logit + tok * NE + 32 * g;
#pragma unroll
        for (int j = 0; j < 8; ++j) {
            const f32x4 v = __builtin_nontemporal_load((const f32x4*)(lp + 4 * j));
#pragma unroll
            for (int e = 0; e < 4; ++e) { const float s = 1.f / (1.f + expf(-v[e])); sc[4 * j + e] = s; bia[4 * j + e] = s + p.r_bias[32 * g + 4 * j + e]; }
        }
        float m1 = -INFINITY, m2 = -INFINITY;
#pragma unroll
        for (int j = 0; j < 32; ++j) { const float v = bia[j]; if (v > m1) { m2 = m1; m1 = v; } else if (v > m2) m2 = v; }
        const float gs = m1 + m2;
        int rank = 0;
#pragma unroll
        for (int o2 = 0; o2 < 8; ++o2) { const float og = shidx(gs, (lane & ~7) | o2, lane); rank += (og > gs || (og == gs && o2 < g)) ? 1 : 0; }
        const bool sel = rank < 4;
        unsigned taken = sel ? 0u : 0xFFFFFFFFu;
        float myscore = 0.f, ssum = 0.f; int myexp = 0;
#pragma unroll 1
        for (int k = 0; k < 8; ++k) {
            float bv = -INFINITY, bs = 0.f; int bi = 0;
#pragma unroll
            for (int j = 0; j < 32; ++j) { const bool free_ = !((taken >> j) & 1u); if (free_ && bia[j] > bv) { bv = bia[j]; bs = sc[j]; bi = j; } }
            int be = 32 * g + bi;
#pragma unroll
            for (int o2 = 1; o2 < 8; o2 <<= 1) {
                const float ov = shx(bv, o2, lane), os = shx(bs, o2, lane); const int oe = shxi(be, o2, lane);
                if (ov > bv || (ov == bv && oe < be)) { bv = ov; bs = os; be = oe; }
            }
            if ((be >> 5) == g) taken |= 1u << (be & 31);
            ssum += bs;
            if (k == g) { myscore = bs; myexp = be; }
        }
        const float gate = myscore / ssum * 2.5f;
        unsigned* cnt = (unsigned*)(p.ws + WS_CTL + CTL_CNT);
        const unsigned pos = atomicAdd(&cnt[myexp], 1u);
        const int asg = (int)tok * 8 + g;
        ((int*)(p.ws + WS_LIST))[(size_t)myexp * LCAP + pos] = asg;
        ((float*)(p.ws + WS_GATE))[asg] = gate;
    }
    __syncthreads();
    {
        f32x16 yd[4][2]; zero_acc<4>(yd);
        const bf16x8* wsw = (const bf16x8*)(p.ws + WS_WDS);
        const bf16x8* wp[4];
#pragma unroll
        for (int i = 0; i < 4; ++i) wp[i] = wsw + (size_t)(4 * wv + i) * 16 * 64 + lane;
        gemm_ct<4, 16>(yd, wp, lds, AP, lane);
        int t0x = t0; asm volatile("" : "+s"(t0x));
#pragma unroll
        for (int tt = 0; tt < 2; ++tt) {
            const size_t tok = t0x + 32 * tt + l31;
#pragma unroll
            for (int i = 0; i < 4; ++i)
#pragma unroll
                for (int g4 = 0; g4 < 4; ++g4) {
                    const int n = 128 * wv + 32 * i + 8 * g4 + 4 * h;
                    f32x4 ov = *(f32x4*)(p.out + tok * DM + n);
#pragma unroll
                    for (int e = 0; e < 4; ++e) ov[e] += gm_l[n + e] * yd[i][tt][4 * g4 + e];
                    *(f32x4*)(p.out + tok * DM + n) = ov;
                }
        }
    }
}

constexpr int EAP = 80;
constexpr int ACTP = 528;
constexpr int L4_ABUF = 0;
constexpr int L4_ACT = 0;
constexpr int L4_ROW = 135168;
constexpr int L4_GATE = L4_ROW + 1024;
constexpr int L4_NCH = L4_GATE + 1024;
constexpr int L4_PFX = L4_NCH + 1024;
constexpr int L4_ITEM = L4_PFX + 1040;
static_assert(L4_ITEM + 16 <= LDS_BARW, "P4 LDS layout");
DI void load_wfrag(float (&dst)[8], const float* base, int ldw, int loff) {
#pragma unroll
    for (int j = 0; j < 8; ++j) dst[j] = (base + (size_t)j * ldw)[loff];
}
DI bf16x8 cvt8(const float (&s)[8]) { bf16x8 v;
#pragma unroll
    for (int j = 0; j < 8; ++j) v[j] = (bf16)s[j];
    return v; }
#ifndef PFW
#define PFW 8
#endif
template <int NRT>
DI void p4_pass(f32x16 (&acc)[NRT], const float* wb, int loff, const bf16* arow, LAS char* lds, int srow, int shalf, int l31, int h) {
#pragma unroll
    for (int rt = 0; rt < NRT; ++rt)
#pragma unroll
        for (int r = 0; r < 16; ++r) acc[rt][r] = 0.f;
    bf16x8 st[2];
#pragma unroll
    for (int i = 0; i < 2; ++i) st[i] = *(const bf16x8*)(arow + 8 * i);
    float raw[PFW][8];
#pragma unroll
    for (int q = 0; q < PFW; ++q) load_wfrag(raw[q], wb + (size_t)q * 16 * ED, ED, loff);
#pragma unroll
    for (int i = 0; i < 2; ++i) *(LAS bf16x8*)(lds + L4_ABUF + srow * EAP + 32 * shalf + 16 * i) = st[i];
    __syncthreads();
#pragma unroll 1
    for (int kc2 = 0; kc2 < 32; kc2 += PFW / 2) {
#pragma unroll
        for (int hf = 0; hf < PFW / 2; ++hf) {
            const int kc = kc2 + hf, cur = kc & 1;
            {
                const int kn = (kc + 1) & 31;
#pragma unroll
                for (int i = 0; i < 2; ++i) st[i] = *(const bf16x8*)(arow + 32 * kn + 8 * i);
            }
            const LAS char* ab = lds + L4_ABUF + cur * (256 * EAP) + l31 * EAP + 16 * h;
#pragma unroll
            for (int s = 0; s < 2; ++s) {
                const int ks = 2 * kc + s, q = 2 * hf + s;
                const bf16x8 wf = cvt8(raw[q]);
                load_wfrag(raw[q], wb + (size_t)((ks + PFW) & 63) * 16 * ED, ED, loff);
#pragma unroll
                for (int g = 0; g < NRT; g += 4) {
                    bf16x8 bt[4];
#pragma unroll
                    for (int rt = 0; rt < 4; ++rt) if (g + rt < NRT) bt[rt] = *(const LAS bf16x8*)(ab + (g + rt) * 32 * EAP + 32 * s);
#pragma unroll
                    for (int rt = 0; rt < 4; ++rt) if (g + rt < NRT) acc[g + rt] = MFMA32(wf, bt[rt], acc[g + rt]);
                }
                __builtin_amdgcn_sched_barrier(0);
            }
#pragma unroll
            for (int i = 0; i < 2; ++i) *(LAS bf16x8*)(lds + L4_ABUF + (cur ^ 1) * (256 * EAP) + srow * EAP + 32 * shalf + 16 * i) = st[i];
            __syncthreads();
        }
    }
}
template <int NRT>
DI void p4_item(const Params& p, LAS char* lds, int e, int nrows, int wv, int vcu) {
    LAS int* rowasg = (LAS int*)(lds + L4_ROW);
    LAS float* rowgate = (LAS float*)(lds + L4_GATE);
    const int lane = lane_opaque(), tid = wv * 64 + lane, h = lane >> 5, l31 = lane & 31, srow = tid >> 1, shalf = tid & 1;
    bf16x8* dump = (bf16x8*)(p.ws + WS_SG) + (size_t)(vcu * NWAVE + wv) * 16 * 64 + lane;
    const bf16* arow = (const bf16*)(p.ws + WS_H2) + (size_t)(rowasg[srow] >> 3) * DM + 16 * shalf;
    bf16* ybuf = (bf16*)(p.ws + WS_Y);
    f32x16 acc[NRT];
    const int loff1 = 8 * h * ED + l31;
    p4_pass<NRT>(acc, p.w_gate_e + (size_t)e * DM * ED + 32 * wv, loff1, arow, lds, srow, shalf, l31, h);
#pragma unroll
    for (int rt = 0; rt < NRT; ++rt) {
        bf16x8 d0, d1;
#pragma unroll
        for (int j = 0; j < 8; ++j) { d0[j] = (bf16)silu_f(acc[rt][j]); d1[j] = (bf16)silu_f(acc[rt][8 + j]); }
        dump[(2 * rt) * 64] = d0; dump[(2 * rt + 1) * 64] = d1;
        __builtin_amdgcn_sched_barrier(0);
    }
    p4_pass<NRT>(acc, p.w_up_e + (size_t)e * DM * ED + 32 * wv, loff1, arow, lds, srow, shalf, l31, h);
    asm volatile("s_waitcnt vmcnt(0)" ::: "memory");
    const bf16x8* dump2 = (const bf16x8*)(p.ws + WS_SG) + (size_t)(vcu * NWAVE + wv) * 16 * 64 + lane_opaque();
#pragma unroll
    for (int rt = 0; rt < NRT; ++rt) {
        const bf16x8 d0 = __builtin_nontemporal_load(&dump2[(2 * rt) * 64]), d1 = __builtin_nontemporal_load(&dump2[(2 * rt + 1) * 64]);
        LAS char* dst = lds + L4_ACT + (32 * rt + l31) * ACTP + (32 * wv + 4 * h) * 2;
#pragma unroll
        for (int g4 = 0; g4 < 4; ++g4) {
            float a[4];
#pragma unroll
            for (int e2 = 0; e2 < 4; ++e2) { const int r = 4 * g4 + e2; a[e2] = (float)(r < 8 ? d0[r] : d1[r - 8]) * acc[rt][r]; }
            *(LAS bf16x4*)(dst + 16 * g4) = pack4(a[0], a[1], a[2], a[3]);
        }
    }
    __syncthreads();
#pragma unroll 1
    for (int np = 0; np < 4; ++np) {
#pragma unroll
        for (int rt = 0; rt < NRT; ++rt)
#pragma unroll
            for (int r = 0; r < 16; ++r) acc[rt][r] = 0.f;
        const int n0 = 256 * np + 32 * wv;
        const float* wdp = p.w_down_e + (size_t)e * ED * DM + n0;
        const int loff2 = 8 * h * DM + l31;
        float raw[PFW][8];
#pragma unroll
        for (int q = 0; q < PFW; ++q) load_wfrag(raw[q], wdp + (size_t)q * 16 * DM, DM, loff2);
        const LAS char* ab = lds + L4_ACT + l31 * ACTP + 16 * h;
#pragma unroll 1
        for (int k4 = 0; k4 < 16; k4 += PFW) {
#pragma unroll
            for (int q = 0; q < PFW; ++q) {
                const int ks = k4 + q;
                const bf16x8 wf = cvt8(raw[q]);
                load_wfrag(raw[q], wdp + (size_t)((ks + PFW) & 15) * 16 * DM, DM, loff2);
#pragma unroll
                for (int g = 0; g < NRT; g += 4) {
                    bf16x8 bt[4];
#pragma unroll
                    for (int rt = 0; rt < 4; ++rt) if (g + rt < NRT) bt[rt] = *(const LAS bf16x8*)(ab + (g + rt) * 32 * ACTP + 32 * ks);
#pragma unroll
                    for (int rt = 0; rt < 4; ++rt) if (g + rt < NRT) acc[g + rt] = MFMA32(wf, bt[rt], acc[g + rt]);
                }
                __builtin_amdgcn_sched_barrier(0);
            }
        }
#pragma unroll
        for (int rt = 0; rt < NRT; ++rt) {
            const int row = 32 * rt + l31;
            if (row < nrows) {
                const float gq = rowgate[row];
                bf16* yr = ybuf + (size_t)rowasg[row] * DM + n0 + 4 * h;
#pragma unroll
                for (int g4 = 0; g4 < 4; ++g4)
                    *(bf16x4*)(yr + 8 * g4) = pack4(acc[rt][4 * g4] * gq, acc[rt][4 * g4 + 1] * gq, acc[rt][4 * g4 + 2] * gq, acc[rt][4 * g4 + 3] * gq);
            }
        }
    }
    __syncthreads();
}
DI void phase4(const Params& p, LAS char* lds, int vcu, int G, int wid, unsigned* qctr) {
    const int wv = wid_opaque(wid);
    const unsigned* cnt = (const unsigned*)(p.ws + WS_CTL + CTL_CNT);
    LAS int* nchs = (LAS int*)(lds + L4_NCH);
    LAS int* pfx = (LAS int*)(lds + L4_PFX);
    LAS int* rowasg = (LAS int*)(lds + L4_ROW);
    LAS float* rowgate = (LAS float*)(lds + L4_GATE);
    volatile LAS int* itemw = (volatile LAS int*)(lds + L4_ITEM);
    {
        const int tid = wv * 64 + lane_opaque();
        if (tid < NE) nchs[tid] = ((int)cnt[tid] + 255) >> 8;
        __syncthreads();
        if (tid <= NE) { int s = 0; for (int j = 0; j < tid; ++j) s += nchs[j]; pfx[tid] = s; }
        __syncthreads();
    }
    const int total = __builtin_amdgcn_readfirstlane(pfx[NE]);
    const int* list = (const int*)(p.ws + WS_LIST);
    const float* gatebuf = (const float*)(p.ws + WS_GATE);
    for (;;) {
        if (wv == 0 && lane_opaque() == 0) itemw[0] = (int)atomicAdd(qctr, 1u);
        __syncthreads();
        const int it = __builtin_amdgcn_readfirstlane(itemw[0]);
        if (it >= total) break;
        int lo = 0, hi = NE - 1;
        while (lo < hi) { const int mid = (lo + hi + 1) >> 1; if (pfx[mid] <= it) lo = mid; else hi = mid - 1; }
        const int e = __builtin_amdgcn_readfirstlane(lo), ch = it - __builtin_amdgcn_readfirstlane(pfx[e]), ne = __builtin_amdgcn_readfirstlane((int)cnt[e]), nch = __builtin_amdgcn_readfirstlane(nchs[e]);
        const int rpc = (((ne + nch - 1) / nch) + 31) & ~31, r0 = ch * rpc, nrows = min(rpc, ne - r0), nrt = (nrows + 31) >> 5;
        {
            const int tid = wv * 64 + lane_opaque();
            if (tid < 256) { const int a = list[(size_t)e * LCAP + r0 + min(tid, nrows - 1)]; rowasg[tid] = a; rowgate[tid] = gatebuf[a]; }
        }
        __syncthreads();
        if (nrt <= 4) p4_item<4>(p, lds, e, nrows, wv, vcu);
        else if (nrt <= 6) p4_item<6>(p, lds, e, nrows, wv, vcu);
        else p4_item<8>(p, lds, e, nrows, wv, vcu);
    }
}

DI void phase5(const Params& p, int vcu, int G, int wid) {
    const bf16* ybuf = (const bf16*)(p.ws + WS_Y);
    const int gtid = vcu * NTHR + tid_of(wid), gth = G * NTHR;
    for (int i = gtid; i < NTOK * (DM / 8); i += gth) {
        const int tok = i >> 7, n = (i & 127) * 8, b = tok / SEQ;
        float s[8];
#pragma unroll
        for (int e = 0; e < 8; ++e) s[e] = 0.f;
#pragma unroll
        for (int k = 0; k < 8; ++k) {
            const bf16x8 v = *(const bf16x8*)(ybuf + ((size_t)tok * 8 + k) * DM + n);
#pragma unroll
            for (int e = 0; e < 8; ++e) s[e] += (float)v[e];
        }
        float* op = p.out + (size_t)tok * DM + n;
        f32x4 o0 = *(f32x4*)op, o1 = *(f32x4*)(op + 4);
        const float* gm = (const float*)(p.ws + WS_MODF) + b * 6144 + 5 * DM + n;
        const f32x4 g0 = *(const f32x4*)gm, g1 = *(const f32x4*)(gm + 4);
#pragma unroll
        for (int e = 0; e < 4; ++e) { o0[e] += g0[e] * s[e]; o1[e] += g1[e] * s[4 + e]; }
        *(f32x4*)op = o0; *(f32x4*)(op + 4) = o1;
    }
}

DI int vcu_of(int bx, int G) { return (G % 8 == 0) ? (bx % 8) * (G / 8) + bx / 8 : bx; }
#if FUSED
__global__ void __launch_bounds__(NTHR) mk_fwd(Params p) {
    extern __shared__ __attribute__((aligned(16))) unsigned char lds_raw[];
    LAS char* lds = (LAS char*)lds_raw;
    const int G = gridDim.x, vcu = vcu_of(blockIdx.x, G);
    const int wid = __builtin_amdgcn_readfirstlane((int)threadIdx.x >> 6);
    volatile LAS unsigned* st = (volatile LAS unsigned*)(lds + LDS_BARW);
    if (tid_of(wid) == 0) { st[0] = 0u; st[1] = 0u; }
    __syncthreads();
    XcdBarrier bar = xcd_barrier_post((unsigned*)(p.ws + WS_CTL), st, wid);
    phase0(p, lds, vcu, G, wid);
    xcd_barrier(bar);
    if (REP == 0) { phase0(p, lds, vcu, G, wid); xcd_barrier(bar); }
    phase1(p, lds, vcu, wid);
    xcd_barrier(bar);
    if (REP == 1) { phase1(p, lds, vcu, wid); xcd_barrier(bar); }
    phase2(p, lds, vcu, G, wid);
    xcd_barrier(bar);
    if (REP == 2) { phase2(p, lds, vcu, G, wid); xcd_barrier(bar); }
    phase3(p, lds, vcu, wid);
    xcd_barrier(bar);
    phase4(p, lds, vcu, G, wid, (unsigned*)(p.ws + WS_CTL + CTL_Q));
    xcd_barrier(bar);
    if (REP == 4) { phase4(p, lds, vcu, G, wid, (unsigned*)(p.ws + WS_CTL + CTL_Q + 256)); xcd_barrier(bar); }
    phase5(p, vcu, G, wid);
}
#else
#define LDSDECL extern __shared__ __attribute__((aligned(16))) unsigned char lds_raw[]; LAS char* lds = (LAS char*)lds_raw; const int G = gridDim.x, vcu = vcu_of(blockIdx.x, G); const int wid = __builtin_amdgcn_readfirstlane((int)threadIdx.x >> 6); (void)lds; (void)vcu;
__global__ void __launch_bounds__(NTHR) k_p0(Params p) { LDSDECL phase0(p, lds, vcu, G, wid); }
__global__ void __launch_bounds__(NTHR) k_p1(Params p) { LDSDECL phase1(p, lds, vcu, wid); }
__global__ void __launch_bounds__(NTHR) k_p2(Params p) { LDSDECL phase2(p, lds, vcu, G, wid); }
__global__ void __launch_bounds__(NTHR) k_p3(Params p) { LDSDECL phase3(p, lds, vcu, wid); }
__global__ void __launch_bounds__(NTHR) k_p4(Params p) { LDSDECL phase4(p, lds, vcu, G, wid, (unsigned*)(p.ws + WS_CTL + CTL_Q)); }
__global__ void __launch_bounds__(NTHR) k_p5(Params p) { LDSDECL phase5(p, vcu, G, wid); }
#endif

extern "C" void kernel_launch(void* const* d_in, const int* in_sizes, int n_in, void* d_out, int out_size, void* d_ws, size_t ws_size, hipStream_t stream) {
    if (n_in != 24 || ws_size < WS_END) { fprintf(stderr, "kernel_launch: unexpected inputs (n_in %d, ws %zu < %zu)\n", n_in, ws_size, (size_t)WS_END); return; }
    Params p{};
    p.x = (const float*)d_in[0]; p.c = (const float*)d_in[1]; p.pos = (const int*)d_in[2];
    p.w_ada = (const float*)d_in[3]; p.b_ada = (const float*)d_in[4]; p.g_mix = (const float*)d_in[5]; p.w_in = (const float*)d_in[6];
    p.g_q_a = (const float*)d_in[7]; p.g_k_a = (const float*)d_in[8]; p.sinks = (const float*)d_in[9]; p.g_q_b = (const float*)d_in[10]; p.g_k_b = (const float*)d_in[11];
    p.g_out_a = (const float*)d_in[12]; p.g_out_b = (const float*)d_in[13]; p.w_out = (const float*)d_in[14]; p.g_ffn = (const float*)d_in[15];
    p.w_router = (const float*)d_in[16]; p.r_bias = (const float*)d_in[17]; p.w_gate_e = (const float*)d_in[18]; p.w_up_e = (const float*)d_in[19]; p.w_down_e = (const float*)d_in[20];
    p.w_gate_s = (const float*)d_in[21]; p.w_up_s = (const float*)d_in[22]; p.w_down_s = (const float*)d_in[23];
    p.out = (float*)d_out; p.ws = (unsigned char*)d_ws;
    hipMemsetAsync((char*)d_ws + WS_CTL, 0, CTL_BYTES, stream);
    const int G = 256;
#if FUSED
    static bool attr_done = false;
    if (!attr_done) { hipFuncSetAttribute((const void*)mk_fwd, hipFuncAttributeMaxDynamicSharedMemorySize, LDS_BYTES); attr_done = true; }
    void* args[] = { &p };
    hipError_t e = hipLaunchCooperativeKernel((const void*)mk_fwd, dim3(G), dim3(NTHR), args, LDS_BYTES, stream);
    if (e != hipSuccess) fprintf(stderr, "cooperative launch failed: %s\n", hipGetErrorString(e));
#else
    static bool attr_done = false;
    if (!attr_done) {
        hipFuncSetAttribute((const void*)k_p0, hipFuncAttributeMaxDynamicSharedMemorySize, LDS_BYTES);
        hipFuncSetAttribute((const void*)k_p1, hipFuncAttributeMaxDynamicSharedMemorySize, LDS_BYTES);
        hipFuncSetAttribute((const void*)k_p2, hipFuncAttributeMaxDynamicSharedMemorySize, LDS_BYTES);
        hipFuncSetAttribute((const void*)k_p3, hipFuncAttributeMaxDynamicSharedMemorySize, LDS_BYTES);
        hipFuncSetAttribute((const void*)k_p4, hipFuncAttributeMaxDynamicSharedMemorySize, LDS_BYTES);
        hipFuncSetAttribute((const void*)k_p5, hipFuncAttributeMaxDynamicSharedMemorySize, LDS_BYTES);
        attr_done = true;
    }
    hipLaunchKernelGGL(k_p0, dim3(G), dim3(NTHR), LDS_BYTES, stream, p);
    hipLaunchKernelGGL(k_p1, dim3(G), dim3(NTHR), LDS_BYTES, stream, p);
    hipLaunchKernelGGL(k_p2, dim3(G), dim3(NTHR), LDS_BYTES, stream, p);
    hipLaunchKernelGGL(k_p3, dim3(G), dim3(NTHR), LDS_BYTES, stream, p);
    hipLaunchKernelGGL(k_p4, dim3(G), dim3(NTHR), LDS_BYTES, stream, p);
    hipLaunchKernelGGL(k_p5, dim3(G), dim3(NTHR), LDS_BYTES, stream, p);
#endif
}
```

```cpp
#include <hip/hip_runtime.h>
#include <stdint.h>
#include <cstdio>

#ifndef FUSED
#define FUSED 1
#endif
#ifndef REP
#define REP -1
#endif

typedef __bf16 bf16;
typedef __attribute__((ext_vector_type(8))) __bf16 bf16x8;
typedef __attribute__((ext_vector_type(4))) __bf16 bf16x4;
typedef __attribute__((ext_vector_type(16))) float f32x16;
typedef __attribute__((ext_vector_type(4))) float f32x4;
typedef __attribute__((ext_vector_type(4))) short s16x4;
typedef __attribute__((ext_vector_type(8))) short s16x8;
#define LAS __attribute__((address_space(3)))
#define DI __device__ __forceinline__
#define MFMA32(a, b, c) __builtin_amdgcn_mfma_f32_32x32x16_bf16((a), (b), (c), 0, 0, 0)

constexpr int NB = 8, SEQ = 2048, DM = 1024, NTOK = NB * SEQ, INW = 2304;
constexpr int KA_OFF = 512, VA_OFF = 640, QB_OFF = 768, KB_OFF = 1280, VB_OFF = 1792;
constexpr int NE = 256, ED = 256, LCAP = NTOK;
constexpr float EPS = 1e-6f;
constexpr int NTHR = 512, NWAVE = 8;
constexpr int PITCH = 2064;
constexpr int LDS_BYTES = 163840;
constexpr int LDS_MISC = 64 * PITCH;
constexpr int LDS_BARW = LDS_BYTES - 16;

constexpr size_t WS_CTL = 0;
constexpr size_t CTL_BYTES = 65536;
constexpr size_t CTL_CNT = 32768;
constexpr size_t CTL_Q = 40960;
constexpr size_t WS_MODP = WS_CTL + CTL_BYTES;
constexpr size_t WS_MODF = WS_MODP + 8ull * 8 * 6144 * 4;
constexpr size_t WS_ROPE = WS_MODF + 8ull * 6144 * 4;
constexpr size_t WS_WIN = WS_ROPE + 2ull * NTOK * 8 * 4;
constexpr size_t WS_WOUT = WS_WIN + (size_t)INW * DM * 2;
constexpr size_t WS_WR = WS_WOUT + (size_t)DM * DM * 2;
constexpr size_t WS_WGS = WS_WR + (size_t)NE * DM * 2;
constexpr size_t WS_WUS = WS_WGS + (size_t)256 * DM * 2;
constexpr size_t WS_WDS = WS_WUS + (size_t)256 * DM * 2;
constexpr size_t WS_QKV = WS_WDS + (size_t)256 * DM * 2;
constexpr size_t WS_OA = WS_QKV + (size_t)NTOK * INW * 2;
constexpr size_t WS_OB = WS_OA + (size_t)NTOK * 512 * 2;
constexpr size_t WS_LSE = WS_OB + 3ull * NTOK * 512 * 2;
constexpr size_t WS_H2 = WS_LSE + 3ull * NTOK * 8 * 4;
constexpr size_t WS_LOG = WS_H2 + (size_t)NTOK * DM * 2;
constexpr size_t WS_GATE = WS_LOG + (size_t)NTOK * NE * 4;
constexpr size_t WS_LIST = WS_GATE + (size_t)NTOK * 8 * 4;
constexpr size_t WS_Y = WS_LIST + (size_t)NE * LCAP * 4;
constexpr size_t WS_SG = WS_Y + ((size_t)NTOK * 8 + 1) * DM * 2;
constexpr size_t WS_END = WS_SG + 256ull * 8 * 16 * 64 * 16;

struct Params {
    const float *x, *c; const int* pos;
    const float *w_ada, *b_ada, *g_mix, *w_in, *g_q_a, *g_k_a, *sinks, *g_q_b, *g_k_b, *g_out_a, *g_out_b, *w_out, *g_ffn, *w_router, *r_bias;
    const float *w_gate_e, *w_up_e, *w_down_e, *w_gate_s, *w_up_s, *w_down_s;
    float* out; unsigned char* ws;
};

DI float shx(float v, int mask, int lane) { return __builtin_bit_cast(float, __builtin_amdgcn_ds_bpermute((lane ^ mask) << 2, __builtin_bit_cast(int, v))); }
DI int shxi(int v, int mask, int lane) { return __builtin_amdgcn_ds_bpermute((lane ^ mask) << 2, v); }
DI float shidx(float v, int src, int lane) { (void)lane; return __builtin_bit_cast(float, __builtin_amdgcn_ds_bpermute(src << 2, __builtin_bit_cast(int, v))); }
DI float wave_sum(float v, int lane) {
#pragma unroll
    for (int o = 1; o < 64; o <<= 1) v += shx(v, o, lane);
    return v;
}
DI int lane_opaque() { int l = (int)__builtin_amdgcn_mbcnt_hi(~0u, __builtin_amdgcn_mbcnt_lo(~0u, 0u)); asm volatile("" : "+v"(l)); return l; }
DI int wid_opaque(int wid) { int w = wid; asm volatile("" : "+s"(w)); return w; }
DI int tid_of(int wid) { return wid_opaque(wid) * 64 + lane_opaque(); }
DI float butterfly32(float (&q)[32], int lane) {
#pragma unroll
    for (int step = 0; step < 5; ++step) {
        const int m = 16 >> step;
        const bool up = (lane & m) != 0;
#pragma unroll
        for (int k = 0; k < m; ++k) { const float a = q[k], b = q[k + m]; const float send = up ? a : b, keep = up ? b : a; q[k] = keep + shx(send, m, lane); }
    }
    return q[0];
}
DI int crow(int r, int h) { return (r & 3) + 8 * (r >> 2) + 4 * h; }
DI float silu_f(float v) { return v * __builtin_amdgcn_rcpf(1.f + __expf(-v)); }
DI float mod_val(const Params& p, int b, int idx) {
    const float* mp = (const float*)(p.ws + WS_MODP);
    float s = p.b_ada[idx];
#pragma unroll
    for (int ks = 0; ks < 8; ++ks) s += mp[(size_t)(ks * 8 + b) * 6144 + idx];
    return s;
}
DI bf16x4 pack4(float a, float b, float c, float d) { bf16x4 v; v[0] = (bf16)a; v[1] = (bf16)b; v[2] = (bf16)c; v[3] = (bf16)d; return v; }

#define XB_TMO      128
#define XB_XCNT(j)  (256  + 64 * (j))
#define XB_XSUB(j)  (1280 + 64 * (j))
#define XB_XGEN(j)  (2304 + 64 * (j))
#define XB_TOP      3328
#define XB_TOPGEN   3392
#define XCD_BAR_WORDS 3456
#define XB_SPIN_CAP (1u << 22)
DI unsigned xb_ld(unsigned* p) { return __hip_atomic_load(p, __ATOMIC_RELAXED, __HIP_MEMORY_SCOPE_AGENT); }
DI unsigned xb_add(unsigned* p, unsigned v) { return __hip_atomic_fetch_add(p, v, __ATOMIC_RELAXED, __HIP_MEMORY_SCOPE_AGENT); }
DI unsigned xb_xcc_id() { return (unsigned)__builtin_amdgcn_s_getreg((3 << 11) | 20) & 0xFu; }
#define XB_SPIN(cond, bar) do { unsigned _sp = 0; while (cond) { __builtin_amdgcn_s_sleep(1); \
    if ((++_sp & 255u) == 0u) { if (xb_ld(&(bar)[XB_TMO])) break; if (_sp > XB_SPIN_CAP) { atomicAdd(&(bar)[XB_TMO], 1u); break; } } } } while (0)
struct XcdBarrier { unsigned* bar; unsigned x; volatile LAS unsigned* st; int wid; };
DI XcdBarrier xcd_barrier_post(unsigned* bar, volatile LAS unsigned* st, int wid) {
    XcdBarrier b; b.bar = bar; b.x = xb_xcc_id(); b.st = st; b.wid = wid;
    if (tid_of(wid) == 0) (void)xb_add(&bar[XB_XCNT(b.x)], 1u);
    return b;
}
DI void xcd_barrier_complete(unsigned* bar, unsigned x, unsigned& nloc, unsigned& nx) {
    const unsigned G = gridDim.x * gridDim.y * gridDim.z;
    unsigned sum, cnt, mine, sp = 0u;
    for (;;) {
        sum = 0u; cnt = 0u; mine = 0u;
#pragma unroll
        for (unsigned j = 0; j < 16; ++j) { const unsigned c = xb_ld(&bar[XB_XCNT(j)]); sum += c; cnt += (c > 0u) ? 1u : 0u; mine = (j == x) ? c : mine; }
        if (sum == G) break;
        __builtin_amdgcn_s_sleep(1);
        if ((++sp & 255u) == 0u) { if (xb_ld(&bar[XB_TMO])) break; if (sp > XB_SPIN_CAP) { atomicAdd(&bar[XB_TMO], 1u); break; } }
    }
    nloc = mine > 0u ? mine : 1u; nx = cnt > 0u ? cnt : 1u;
}
DI void xcd_barrier(const XcdBarrier& b) {
    asm volatile("s_waitcnt vmcnt(0)" ::: "memory");
    __syncthreads();
    if (tid_of(b.wid) == 0) {
        unsigned* bar = b.bar;
        __builtin_amdgcn_s_waitcnt(0);
        unsigned nloc = b.st[0], nx = b.st[1];
        if (nloc == 0u) { xcd_barrier_complete(bar, b.x, nloc, nx); b.st[0] = nloc; b.st[1] = nx; }
        const unsigned old = xb_add(&bar[XB_XSUB(b.x)], 1u);
        const unsigned gen = old / nloc;
        if (old + 1u == (gen + 1u) * nloc) {
            __builtin_amdgcn_fence(__ATOMIC_RELEASE, "agent");
            asm volatile("s_waitcnt vmcnt(0)" ::: "memory");
            const unsigned og = xb_add(&bar[XB_TOP], 1u);
            const unsigned tg = og / nx;
            if (og + 1u == (tg + 1u) * nx) xb_add(&bar[XB_TOPGEN], 1u);
            else XB_SPIN(xb_ld(&bar[XB_TOPGEN]) == tg, bar);
            __builtin_amdgcn_fence(__ATOMIC_ACQUIRE, "agent");
            xb_add(&bar[XB_XGEN(b.x)], 1u);
            asm volatile("s_waitcnt vmcnt(0)" ::: "memory");
        } else {
            XB_SPIN(xb_ld(&bar[XB_XGEN(b.x)]) == gen, bar);
            __builtin_amdgcn_fence(__ATOMIC_ACQUIRE, "agent");
            asm volatile("s_waitcnt vmcnt(0)" ::: "memory");
        }
    }
    __syncthreads();
}

template <int NT, int KS, bool CL = false>
DI void gemm_ct(f32x16 (&acc)[NT][2], const bf16x8* const (&wp)[NT], const LAS char* panel, int pitch, int lane) {
    const LAS char* b0 = panel + (lane & 31) * pitch + (lane >> 5) * 16;
    const LAS char* b1 = b0 + 32 * pitch;
    constexpr int PF = (NT >= 4) ? 2 : 4;
    bf16x8 w[PF][NT];
#pragma unroll
    for (int q = 0; q < PF; ++q)
#pragma unroll
        for (int i = 0; i < NT; ++i) w[q][i] = wp[i][q * 64];
#pragma unroll 1
    for (int ks0 = 0; ks0 < KS; ks0 += PF) {
#pragma unroll
        for (int q = 0; q < PF; ++q) {
            const int ks = ks0 + q;
            bf16x8 a[NT];
#pragma unroll
            for (int i = 0; i < NT; ++i) a[i] = w[q][i];
#pragma unroll
            for (int i = 0; i < NT; ++i) w[q][i] = wp[i][((ks + PF) & (KS - 1)) * 64];
            const bf16x8 t0 = *(const LAS bf16x8*)(b0 + ks * 32);
            const bf16x8 t1 = *(const LAS bf16x8*)(b1 + ks * 32);
#pragma unroll
            for (int i = 0; i < NT; ++i) {
                if (CL) { acc[i][0] = MFMA32(t0, a[i], acc[i][0]); acc[i][1] = MFMA32(t1, a[i], acc[i][1]); }
                else    { acc[i][0] = MFMA32(a[i], t0, acc[i][0]); acc[i][1] = MFMA32(a[i], t1, acc[i][1]); }
            }
            __builtin_amdgcn_sched_barrier(0);
        }
    }
}
template <int NT> DI void zero_acc(f32x16 (&acc)[NT][2]) {
#pragma unroll
    for (int i = 0; i < NT; ++i)
#pragma unroll
        for (int t = 0; t < 2; ++t)
#pragma unroll
            for (int r = 0; r < 16; ++r) acc[i][t][r] = 0.f;
}

DI void convert_sw(const float* W, int K, int N, bf16x8* dst, const float* sa, const float* sb, int gtid, int gthreads, bool il4 = false) {
    const int KS = K / 16, total = (N / 32) * KS * 64;
    for (int pc = gtid; pc < total; pc += gthreads) {
        const int l = pc & 63, ks = (pc >> 6) % KS, nt = (pc >> 6) / KS;
        const int n = il4 ? 128 * (nt >> 2) + 4 * (l & 31) + (nt & 3) : 32 * nt + (l & 31), k0 = 16 * ks + 8 * (l >> 5);
        bf16x8 v;
#pragma unroll
        for (int j = 0; j < 8; ++j) {
            float w = W[(size_t)(k0 + j) * N + n];
            if (sa) { const int k = k0 + j; w *= (k < 512) ? sa[k] : sb[k - 512]; }
            v[j] = (bf16)w;
        }
        dst[pc] = v;
    }
}
DI void phase0(const Params& p, LAS char* lds, int vcu, int G, int wid) {
    const int lane = lane_opaque(), wv = wid_opaque(wid), tid = wv * 64 + lane;
    LAS float* red = (LAS float*)lds;
    for (int it = vcu; it < 96 * 8; it += G) {
        const int cc = it % 96, ks = it / 96;
        float acc[8];
#pragma unroll
        for (int b = 0; b < 8; ++b) acc[b] = 0.f;
        const int n = 64 * cc + lane;
        for (int i = 0; i < 16; ++i) {
            const int k = 128 * ks + 16 * wv + i;
            const float w = p.w_ada[(size_t)k * 6144 + n];
#pragma unroll
            for (int b = 0; b < 8; ++b) acc[b] += silu_f(p.c[b * DM + k]) * w;
        }
#pragma unroll
        for (int b = 0; b < 8; ++b) red[(wv * 8 + b) * 64 + lane] = acc[b];
        __syncthreads();
        {
            const int b = tid >> 6, col = tid & 63;
            float s = 0.f;
#pragma unroll
            for (int w8 = 0; w8 < 8; ++w8) s += red[(w8 * 8 + b) * 64 + col];
            ((float*)(p.ws + WS_MODP))[(size_t)(ks * 8 + b) * 6144 + 64 * cc + col] = s;
        }
        __syncthreads();
    }
    const int gtid = vcu * NTHR + tid, gth = G * NTHR;
    convert_sw(p.w_in, DM, INW, (bf16x8*)(p.ws + WS_WIN), nullptr, nullptr, gtid, gth);
    convert_sw(p.w_out, DM, DM, (bf16x8*)(p.ws + WS_WOUT), p.g_out_a, p.g_out_b, gtid, gth, true);
    convert_sw(p.w_router, DM, NE, (bf16x8*)(p.ws + WS_WR), nullptr, nullptr, gtid, gth);
    convert_sw(p.w_gate_s, DM, 256, (bf16x8*)(p.ws + WS_WGS), nullptr, nullptr, gtid, gth);
    convert_sw(p.w_up_s, DM, 256, (bf16x8*)(p.ws + WS_WUS), nullptr, nullptr, gtid, gth);
    convert_sw(p.w_down_s, 256, DM, (bf16x8*)(p.ws + WS_WDS), nullptr, nullptr, gtid, gth, true);
    float* cosT = (float*)(p.ws + WS_ROPE); float* sinT = cosT + (size_t)NTOK * 8;
    for (int e = gtid; e < NTOK * 8; e += gth) {
        const int t = e >> 3, i = e & 7;
        const float inv = (float)exp2(-(double)i * 0.125 * 18.931568569324174);
        const float ang = (float)p.pos[t] * inv;
        double rev = (double)ang * 0.15915494309189535; rev -= floor(rev);
        cosT[e] = __builtin_amdgcn_cosf((float)rev);
        sinT[e] = __builtin_amdgcn_sinf((float)rev);
    }
}

DI void phase1(const Params& p, LAS char* lds, int wg, int wid) {
    const int lane = lane_opaque(), wv = wid_opaque(wid), tid = wv * 64 + lane;
    const int t0 = wg * 64, b = t0 / SEQ;
    if (tid < 192) { const int idx = (wg & 31) * 192 + tid; ((float*)(p.ws + WS_MODF))[b * 6144 + idx] = mod_val(p, b, idx); }
    {
        float ga[16], sh[16];
#pragma unroll
        for (int j = 0; j < 4; ++j)
#pragma unroll
            for (int e = 0; e < 4; ++e) {
                const int k = 256 * j + 4 * lane + e;
                ga[4 * j + e] = p.g_mix[k] * (1.f + mod_val(p, b, 1 * DM + k));
                sh[4 * j + e] = mod_val(p, b, 0 * DM + k);
            }
#pragma unroll 1
        for (int i = 0; i < 8; ++i) {
            const int row = 8 * wv + i;
            const float* xr = p.x + (size_t)(t0 + row) * DM;
            f32x4 v[4]; float ss = 0.f;
#pragma unroll
            for (int j = 0; j < 4; ++j) { v[j] = *(const f32x4*)(xr + 256 * j + 4 * lane); ss += v[j][0] * v[j][0] + v[j][1] * v[j][1] + v[j][2] * v[j][2] + v[j][3] * v[j][3]; }
            const float rstd = rsqrtf(wave_sum(ss, lane) * (1.f / DM) + EPS);
#pragma unroll
            for (int j = 0; j < 4; ++j) {
                const bf16x4 o = pack4(v[j][0] * rstd * ga[4 * j] + sh[4 * j], v[j][1] * rstd * ga[4 * j + 1] + sh[4 * j + 1],
                                       v[j][2] * rstd * ga[4 * j + 2] + sh[4 * j + 2], v[j][3] * rstd * ga[4 * j + 3] + sh[4 * j + 3]);
                *(LAS bf16x4*)(lds + row * PITCH + (256 * j + 4 * lane) * 2) = o;
            }
        }
    }
    __syncthreads();
    const bf16x8* wsw = (const bf16x8*)(p.ws + WS_WIN);
    const float* cosT = (const float*)(p.ws + WS_ROPE); const float* sinT = cosT + (size_t)NTOK * 8;
    bf16* qkv = (bf16*)(p.ws + WS_QKV);
    const int h = lane >> 5;
#pragma unroll 1
    for (int u = wv; u < 36; u += NWAVE) {
        f32x16 acc[2][2]; zero_acc<2>(acc);
        const bf16x8* wp[2] = { wsw + (size_t)(2 * u) * 64 * 64 + lane, wsw + (size_t)(2 * u + 1) * 64 * 64 + lane };
        gemm_ct<2, 64>(acc, wp, lds, PITCH, lane);
        const float* g = nullptr; float qs = 1.f;
        if (u < 8) { g = p.g_q_a; qs = 0.125f; } else if (u < 10) g = p.g_k_a; else if (u >= 12 && u < 20) { g = p.g_q_b; qs = 0.125f; } else if (u >= 20 && u < 28) g = p.g_k_b;
#pragma unroll
        for (int tt = 0; tt < 2; ++tt) {
            const int tok = t0 + 32 * tt + (lane & 31);
            if (g) {
                float ss = 0.f;
#pragma unroll
                for (int nt = 0; nt < 2; ++nt)
#pragma unroll
                    for (int r = 0; r < 16; ++r) ss += acc[nt][tt][r] * acc[nt][tt][r];
                ss += shx(ss, 32, lane);
                const float rstd = rsqrtf(ss * (1.f / 64.f) + EPS);
#pragma unroll
                for (int nt = 0; nt < 2; ++nt)
#pragma unroll
                    for (int r = 0; r < 16; ++r) acc[nt][tt][r] *= rstd * g[32 * nt + crow(r, h)];
#pragma unroll
                for (int r = 0; r < 4; ++r) {
                    const int i = r + 4 * h;
                    const float cs = cosT[(size_t)tok * 8 + i], sn = sinT[(size_t)tok * 8 + i];
                    const float a1 = acc[0][tt][r], a2 = acc[0][tt][r + 4];
                    acc[0][tt][r] = a1 * cs - a2 * sn; acc[0][tt][r + 4] = a2 * cs + a1 * sn;
                }
            }
#pragma unroll
            for (int nt = 0; nt < 2; ++nt)
#pragma unroll
                for (int g4 = 0; g4 < 4; ++g4) {
                    const bf16x4 o = pack4(acc[nt][tt][4 * g4] * qs, acc[nt][tt][4 * g4 + 1] * qs, acc[nt][tt][4 * g4 + 2] * qs, acc[nt][tt][4 * g4 + 3] * qs);
                    *(bf16x4*)(qkv + (size_t)tok * INW + 64 * u + 32 * nt + 8 * g4 + 4 * h) = o;
                }
        }
    }
}

constexpr int VP = 192;
DI void attn_unit(const Params& p, LAS char* vimg, int u, int lane) {
    const int combo = u & 31, blk = (u >> 5) & 31, b = u >> 10;
    const int h = lane >> 5, l31 = lane & 31;
    int qoff, koff, voff, dil, maxd; float m_init, l_init; bf16* outp; float* lsep = nullptr; int hb;
    if (combo < 8) {
        hb = combo; qoff = 64 * hb; koff = KA_OFF + 64 * (hb >> 2); voff = VA_OFF + 64 * (hb >> 2); dil = 1; maxd = 127;
        m_init = p.sinks[hb]; l_init = 1.f; outp = (bf16*)(p.ws + WS_OA);
    } else {
        const int br = (combo - 8) >> 3; hb = (combo - 8) & 7;
        qoff = QB_OFF + 64 * hb; koff = KB_OFF + 64 * hb; voff = VB_OFF + 64 * hb; dil = (br == 0) ? 1 : (br == 1 ? 4 : 16); maxd = 128;
        m_init = -1e30f; l_init = 0.f; outp = (bf16*)(p.ws + WS_OB) + (size_t)br * NTOK * 512; lsep = (float*)(p.ws + WS_LSE) + (size_t)br * NTOK * 8;
    }
    const int L = SEQ / dil, nb = L / 64, rho = blk / nb, l0 = (blk % nb) * 64;
    const bf16* qkv = (const bf16*)(p.ws + WS_QKV) + (size_t)b * SEQ * INW;
    bf16x8 qf[2][4];
#pragma unroll
    for (int qt = 0; qt < 2; ++qt) {
        const bf16* qp = qkv + (size_t)((l0 + 32 * qt + l31) * dil + rho) * INW + qoff + 8 * h;
#pragma unroll
        for (int s = 0; s < 4; ++s) qf[qt][s] = *(const bf16x8*)(qp + 16 * s);
    }
    f32x16 o[2][2];
#pragma unroll
    for (int dt = 0; dt < 2; ++dt)
#pragma unroll
        for (int qt = 0; qt < 2; ++qt)
#pragma unroll
            for (int r = 0; r < 16; ++r) o[dt][qt][r] = 0.f;
    float mrun[2] = { m_init, m_init }, lrun[2] = { h == 0 ? l_init : 0.f, h == 0 ? l_init : 0.f };
    const float LOG2E = 1.4426950408889634f;
#pragma unroll 1
    for (int kt = 0; kt < 6; ++kt) {
        const int lk0 = l0 - 128 + 32 * kt;
        if (lk0 + 31 < 0) continue;
        bf16x8 kf[4];
        {
            int lk = lk0 + l31; lk = lk < 0 ? 0 : lk;
            const bf16* kp = qkv + (size_t)(lk * dil + rho) * INW + koff + 8 * h;
#pragma unroll
            for (int s = 0; s < 4; ++s) kf[s] = *(const bf16x8*)(kp + 16 * s);
        }
        {
            bf16x8 vr[4];
#pragma unroll
            for (int i = 0; i < 4; ++i) {
                int lk = lk0 + (lane >> 3) + 8 * i; lk = lk < 0 ? 0 : lk;
                vr[i] = *(const bf16x8*)(qkv + (size_t)(lk * dil + rho) * INW + voff + 8 * (lane & 7));
            }
#pragma unroll
            for (int i = 0; i < 4; ++i) *(LAS bf16x8*)(vimg + ((lane >> 3) + 8 * i) * VP + 16 * (lane & 7)) = vr[i];
        }
        bf16x8 vf[2][2];
        {
            const int g1 = (lane >> 4) & 1, q4 = (lane & 15) >> 2, p4 = lane & 3;
#pragma unroll
            for (int dt = 0; dt < 2; ++dt)
#pragma unroll
                for (int s = 0; s < 2; ++s) {
                    const LAS char* a0 = vimg + (16 * s + 4 * h + q4) * VP + (32 * dt + 16 * g1 + 4 * p4) * 2;
                    const s16x4 lo = __builtin_amdgcn_ds_read_tr16_b64_v4i16((LAS s16x4*)a0);
                    const s16x4 hi = __builtin_amdgcn_ds_read_tr16_b64_v4i16((LAS s16x4*)(a0 + 8 * VP));
                    const s16x8 c = __builtin_shufflevector(lo, hi, 0, 1, 2, 3, 4, 5, 6, 7);
                    vf[dt][s] = __builtin_bit_cast(bf16x8, c);
                }
        }
#pragma unroll
        for (int qt = 0; qt < 2; ++qt) {
            if ((qt == 0 && kt == 5) || (qt == 1 && kt == 0)) continue;
            f32x16 sacc;
#pragma unroll
            for (int r = 0; r < 16; ++r) sacc[r] = 0.f;
#pragma unroll
            for (int s = 0; s < 4; ++s) sacc = MFMA32(kf[s], qf[qt][s], sacc);
            const int lq = l0 + 32 * qt + l31;
            float mx = -1e30f;
#pragma unroll
            for (int r = 0; r < 16; ++r) {
                const int lk = lk0 + crow(r, h), d = lq - lk;
                const bool ok = (lk >= 0) && (d >= 0) && (d <= maxd);
                sacc[r] = ok ? sacc[r] : -1e30f;
                mx = fmaxf(mx, sacc[r]);
            }
            mx = fmaxf(mx, shx(mx, 32, lane));
            const float mnew = fmaxf(mrun[qt], mx);
            const float alpha = exp2f((mrun[qt] - mnew) * LOG2E);
            float ps = 0.f;
#pragma unroll
            for (int r = 0; r < 16; ++r) { sacc[r] = exp2f((sacc[r] - mnew) * LOG2E); ps += sacc[r]; }
            lrun[qt] = lrun[qt] * alpha + ps; mrun[qt] = mnew;
#pragma unroll
            for (int dt = 0; dt < 2; ++dt)
#pragma unroll
                for (int r = 0; r < 16; ++r) o[dt][qt][r] *= alpha;
            bf16x8 pf[2];
#pragma unroll
            for (int s = 0; s < 2; ++s)
#pragma unroll
                for (int j = 0; j < 8; ++j) pf[s][j] = (bf16)sacc[8 * s + j];
#pragma unroll
            for (int dt = 0; dt < 2; ++dt)
#pragma unroll
                for (int s = 0; s < 2; ++s) o[dt][qt] = MFMA32(vf[dt][s], pf[s], o[dt][qt]);
        }
    }
#pragma unroll
    for (int qt = 0; qt < 2; ++qt) {
        const float lt = lrun[qt] + shx(lrun[qt], 32, lane);
        const float inv = 1.f / lt;
        const size_t tok = (size_t)b * SEQ + (size_t)(l0 + 32 * qt + l31) * dil + rho;
#pragma unroll
        for (int dt = 0; dt < 2; ++dt)
#pragma unroll
            for (int g4 = 0; g4 < 4; ++g4) {
                const bf16x4 v = pack4(o[dt][qt][4 * g4] * inv, o[dt][qt][4 * g4 + 1] * inv, o[dt][qt][4 * g4 + 2] * inv, o[dt][qt][4 * g4 + 3] * inv);
                *(bf16x4*)(outp + tok * 512 + 64 * hb + 32 * dt + 8 * g4 + 4 * h) = v;
            }
        if (lsep && h == 0) lsep[tok * 8 + hb] = mrun[qt] + logf(lt);
    }
}
DI void phase2(const Params& p, LAS char* lds, int vcu, int G, int wid) {
    const int lane = lane_opaque(), wv = wid_opaque(wid), tid = wv * 64 + lane;
    LAS char* vimg = lds + wv * (32 * VP);
    for (int u = vcu * NWAVE + wv; u < 8192; u += G * NWAVE) attn_unit(p, vimg, u, lane);
}

DI void phase3(const Params& p, LAS char* lds, int wg, int wid) {
    const int lane = lane_opaque(), wv = wid_opaque(wid), tid = wv * 64 + lane, h = lane >> 5, l31 = lane & 31;
    const int t0 = wg * 64, b = t0 / SEQ;
    LAS float* ga_l = (LAS float*)(lds + LDS_MISC + 2048);
    LAS float* hs_l = ga_l + 1024;
    LAS float* sh_l = hs_l + 1024;
    LAS float* gm_l = sh_l + 1024;
    {
        const float* mf = (const float*)(p.ws + WS_MODF) + b * 6144;
        for (int n = tid; n < DM; n += NTHR) { ga_l[n] = mf[2 * DM + n]; hs_l[n] = p.g_ffn[n] * (1.f + mf[4 * DM + n]); sh_l[n] = mf[3 * DM + n]; gm_l[n] = mf[5 * DM + n]; }
    }
    {
        const bf16* oa = (const bf16*)(p.ws + WS_OA); const bf16* ob = (const bf16*)(p.ws + WS_OB); const float* lse = (const float*)(p.ws + WS_LSE);
#pragma unroll 1
        for (int ib = 0; ib < 2; ++ib) {
            bf16x8 d[4][3][2]; float e3[4][3];
#pragma unroll
            for (int i = 0; i < 4; ++i) {
                const size_t tok = t0 + 8 * wv + 4 * ib + i;
                if (h == 0) {
                    d[i][0][0] = *(const bf16x8*)(oa + tok * 512 + 16 * l31); d[i][0][1] = *(const bf16x8*)(oa + tok * 512 + 16 * l31 + 8);
                } else {
                    const int hd = l31 >> 2;
#pragma unroll
                    for (int br = 0; br < 3; ++br) {
                        const bf16* src = ob + (size_t)br * NTOK * 512 + tok * 512 + 16 * l31;
                        d[i][br][0] = *(const bf16x8*)src; d[i][br][1] = *(const bf16x8*)(src + 8);
                        e3[i][br] = lse[(size_t)br * NTOK * 8 + tok * 8 + hd];
                    }
                }
            }
#pragma unroll
            for (int i = 0; i < 4; ++i) {
                const int row = 8 * wv + 4 * ib + i;
                float v[16];
                if (h == 0) {
#pragma unroll
                    for (int j = 0; j < 8; ++j) { v[j] = (float)d[i][0][0][j]; v[8 + j] = (float)d[i][0][1][j]; }
                } else {
                    const float mx = fmaxf(e3[i][0], fmaxf(e3[i][1], e3[i][2]));
                    float w0 = __expf(e3[i][0] - mx), w1 = __expf(e3[i][1] - mx), w2 = __expf(e3[i][2] - mx);
                    const float wi = 1.f / (w0 + w1 + w2); w0 *= wi; w1 *= wi; w2 *= wi;
#pragma unroll
                    for (int j = 0; j < 8; ++j) {
                        v[j] = w0 * (float)d[i][0][0][j] + w1 * (float)d[i][1][0][j] + w2 * (float)d[i][2][0][j];
                        v[8 + j] = w0 * (float)d[i][0][1][j] + w1 * (float)d[i][1][1][j] + w2 * (float)d[i][2][1][j];
                    }
                }
                float ss = 0.f;
#pragma unroll
                for (int j = 0; j < 16; ++j) ss += v[j] * v[j];
#pragma unroll
                for (int o2 = 1; o2 < 32; o2 <<= 1) ss += shx(ss, o2, lane);
                const float rstd = rsqrtf(ss * (1.f / 512.f) + EPS);
                bf16x8 o0, o1;
#pragma unroll
                for (int j = 0; j < 8; ++j) { o0[j] = (bf16)(v[j] * rstd); o1[j] = (bf16)(v[8 + j] * rstd); }
                LAS char* dst = lds + row * PITCH + (512 * h + 16 * l31) * 2;
                *(LAS bf16x8*)dst = o0; *(LAS bf16x8*)(dst + 16) = o1;
            }
        }
    }
    __syncthreads();
    f32x16 x1[4][2]; zero_acc<4>(x1);
    {
        const bf16x8* wsw = (const bf16x8*)(p.ws + WS_WOUT);
        const bf16x8* wp[4];
#pragma unroll
        for (int i = 0; i < 4; ++i) wp[i] = wsw + (size_t)(4 * wv + i) * 64 * 64 + lane;
        gemm_ct<4, 64, true>(x1, wp, lds, PITCH, lane);
    }
    LAS float* ssx = (LAS float*)(lds + LDS_MISC);
    LAS float* rsx = (LAS float*)(lds + LDS_MISC + 18432);
    {
        const int lane = lane_opaque(), h = lane >> 5, l31 = lane & 31, nb = 128 * wv + 4 * l31;
        const f32x4 ga4 = *(const LAS f32x4*)(ga_l + nb);
        float q[32];
#pragma unroll
        for (int tt = 0; tt < 2; ++tt)
#pragma unroll
            for (int r = 0; r < 16; ++r) {
                const size_t tok = t0 + 32 * tt + crow(r, h);
                const f32x4 xv = *(const f32x4*)(p.x + tok * DM + nb);
                f32x4 ov; float ss = 0.f;
#pragma unroll
                for (int e = 0; e < 4; ++e) { const float v = xv[e] + ga4[e] * x1[e][tt][r]; x1[e][tt][r] = v; ov[e] = v; ss += v * v; }
                *(f32x4*)(p.out + tok * DM + nb) = ov;
                q[16 * tt + r] = ss;
                if ((r & 7) == 7) __builtin_amdgcn_sched_barrier(0);
            }
        const float tot = butterfly32(q, lane);
        ssx[wv * 64 + 32 * (l31 >> 4) + crow(l31 & 15, h)] = tot;
    }
    __syncthreads();
    { const int tid2 = wv * 64 + lane_opaque();
      if (tid2 < 64) { float ss = 0.f;
#pragma unroll
        for (int w8 = 0; w8 < 8; ++w8) ss += ssx[w8 * 64 + tid2];
        rsx[tid2] = rsqrtf(ss * (1.f / DM) + EPS); } }
    __syncthreads();
    {
        const int lane = lane_opaque(), h = lane >> 5, l31 = lane & 31, nb = 128 * wv + 4 * l31;
        bf16* h2g = (bf16*)(p.ws + WS_H2);
        const f32x4 hs4 = *(const LAS f32x4*)(hs_l + nb), sh4 = *(const LAS f32x4*)(sh_l + nb);
#pragma unroll
        for (int tt = 0; tt < 2; ++tt)
#pragma unroll
            for (int r = 0; r < 16; ++r) {
                const int row = 32 * tt + crow(r, h); const size_t tok = t0 + row;
                const float rstd = rsx[row];
                const bf16x4 o = pack4(x1[0][tt][r] * rstd * hs4[0] + sh4[0], x1[1][tt][r] * rstd * hs4[1] + sh4[1], x1[2][tt][r] * rstd * hs4[2] + sh4[2], x1[3][tt][r] * rstd * hs4[3] + sh4[3]);
                *(LAS bf16x4*)(lds + row * PITCH + nb * 2) = o;
                *(bf16x4*)(h2g + tok * DM + nb) = o;
                if ((r & 3) == 3) __builtin_amdgcn_sched_barrier(0);
            }
    }
    __syncthreads();
    float* logit = (float*)(p.ws + WS_LOG);
    {
        f32x16 ra[1][2]; zero_acc<1>(ra);
        const bf16x8* wp[1] = { (const bf16x8*)(p.ws + WS_WR) + (size_t)wv * 64 * 64 + lane };
        gemm_ct<1, 64, true>(ra, wp, lds, PITCH, lane);
        const int lane = lane_opaque(), h = lane >> 5, l31 = lane & 31;
#pragma unroll
        for (int tt = 0; tt < 2; ++tt)
#pragma unroll
            for (int r = 0; r < 16; ++r) logit[(size_t)(t0 + 32 * tt + crow(r, h)) * NE + 32 * wv + l31] = ra[0][tt][r];
    }
    f32x16 gu[2][2]; zero_acc<2>(gu);
    {
        const bf16x8* wp[2] = { (const bf16x8*)(p.ws + WS_WGS) + (size_t)wv * 64 * 64 + lane, (const bf16x8*)(p.ws + WS_WUS) + (size_t)wv * 64 * 64 + lane };
        gemm_ct<2, 64, true>(gu, wp, lds, PITCH, lane);
    }
    asm volatile("s_waitcnt vmcnt(0)" ::: "memory");
    __syncthreads();
    constexpr int AP = 528;
    { const int lane = lane_opaque(), h = lane >> 5, l31 = lane & 31;
#pragma unroll
      for (int tt = 0; tt < 2; ++tt)
#pragma unroll
        for (int r = 0; r < 16; ++r)
            *(LAS bf16*)(lds + (32 * tt + crow(r, h)) * AP + (32 * wv + l31) * 2) = (bf16)(silu_f(gu[0][tt][r]) * gu[1][tt][r]); }
    {
        const int lane = lane_opaque(); int t0y = t0; asm volatile("" : "+s"(t0y));
        const int g = lane & 7; const size_t tok = t0y + 8 * wv + (lane >> 3);
        float bia[32], sc[32];
        const float* lp = logit + tok * NE + 32 * g;
#pragma unroll
        for (int j = 0; j < 8; ++j) {
            const f32x4 v = __builtin_nontemporal_load((const f32x4*)(lp + 4 * j));
#pragma unroll
            for (int e = 0; e < 4; ++e) { const float s = 1.f / (1.f + expf(-v[e])); sc[4 * j + e] = s; bia[4 * j + e] = s + p.r_bias[32 * g + 4 * j + e]; }
        }
        float m1 = -INFINITY, m2 = -INFINITY;
#pragma unroll
        for (int j = 0; j < 32; ++j) { const float v = bia[j]; if (v > m1) { m2 = m1; m1 = v; } else if (v > m2) m2 = v; }
        const float gs = m1 + m2;
        int rank = 0;
#pragma unroll
        for (int o2 = 0; o2 < 8; ++o2) { const float og = shidx(gs, (lane & ~7) | o2, lane); rank += (og > gs || (og == gs && o2 < g)) ? 1 : 0; }
        const bool sel = rank < 4;
        unsigned taken = sel ? 0u : 0xFFFFFFFFu;
        float myscore = 0.f, ssum = 0.f; int myexp = 0;
#pragma unroll 1
        for (int k = 0; k < 8; ++k) {
            float bv = -INFINITY, bs = 0.f; int bi = 0;
#pragma unroll
            for (int j = 0; j < 32; ++j) { const bool free_ = !((taken >> j) & 1u); if (free_ && bia[j] > bv) { bv = bia[j]; bs = sc[j]; bi = j; } }
            int be = 32 * g + bi;
#pragma unroll
            for (int o2 = 1; o2 < 8; o2 <<= 1) {
                const float ov = shx(bv, o2, lane), os = shx(bs, o2, lane); const int oe = shxi(be, o2, lane);
                if (ov > bv || (ov == bv && oe < be)) { bv = ov; bs = os; be = oe; }
            }
            if ((be >> 5) == g) taken |= 1u << (be & 31);
            ssum += bs;
            if (k == g) { myscore = bs; myexp = be; }
        }
        const float gate = myscore / ssum * 2.5f;
        unsigned* cnt = (unsigned*)(p.ws + WS_CTL + CTL_CNT);
        const unsigned pos = atomicAdd(&cnt[myexp], 1u);
        const int asg = (int)tok * 8 + g;
        ((int*)(p.ws + WS_LIST))[(size_t)myexp * LCAP + pos] = asg;
        ((float*)(p.ws + WS_GATE))[asg] = gate;
    }
    __syncthreads();
    {
        f32x16 yd[4][2]; zero_acc<4>(yd);
        const bf16x8* wsw = (const bf16x8*)(p.ws + WS_WDS);
        const bf16x8* wp[4];
#pragma unroll
        for (int i = 0; i < 4; ++i) wp[i] = wsw + (size_t)(4 * wv + i) * 16 * 64 + lane;
        gemm_ct<4, 16, true>(yd, wp, lds, AP, lane);
        int t0x = t0; asm volatile("" : "+s"(t0x));
        const int lane2 = lane_opaque(), nb2 = 128 * wv + 4 * (lane2 & 31), h2 = lane2 >> 5;
        const f32x4 gm4 = *(const LAS f32x4*)(gm_l + nb2);
#pragma unroll
        for (int tt = 0; tt < 2; ++tt)
#pragma unroll
            for (int r = 0; r < 16; ++r) {
                float* op = p.out + (size_t)(t0x + 32 * tt + crow(r, h2)) * DM + nb2;
                f32x4 ov = *(f32x4*)op;
#pragma unroll
                for (int e = 0; e < 4; ++e) ov[e] += gm4[e] * yd[e][tt][r];
                *(f32x4*)op = ov;
                if ((r & 7) == 7) __builtin_amdgcn_sched_barrier(0);
            }
    }
}

constexpr int EAP = 144;
constexpr int ACTP = 528;
constexpr int L4_ABUF = 0;
constexpr int L4_ACT = 0;
constexpr int L4_ROW = 135168;
constexpr int L4_GATE = L4_ROW + 1024;
constexpr int L4_YOFF = L4_GATE + 1024;
constexpr int L4_NCH = L4_YOFF + 1024;
constexpr int L4_PFX = L4_NCH + 1024;
constexpr int L4_ITEM = L4_PFX + 1040;
constexpr int L4_WSC = 141312;
constexpr int WSC_BYTES = 2560;
static_assert(L4_ITEM + 16 <= L4_WSC && L4_WSC + 8 * WSC_BYTES + 8 * 33 * 4 <= LDS_BARW, "P4 LDS layout");
struct WRaw { f32x4 v[2]; };
DI void load_wraw(WRaw& d, const float* base, int ld, int loff) {
    d.v[0] = *(const f32x4*)(base + loff);
    d.v[1] = *(const f32x4*)(base + (size_t)8 * ld + loff);
}
DI bf16x8 wfrag_from(const WRaw& d, LAS char* wsc, int lane) {
    const int wo = (lane >> 3) * 64 + (lane & 7) * 8;
    *(LAS bf16x4*)(wsc + wo) = pack4(d.v[0][0], d.v[0][1], d.v[0][2], d.v[0][3]);
    *(LAS bf16x4*)(wsc + wo + 512) = pack4(d.v[1][0], d.v[1][1], d.v[1][2], d.v[1][3]);
    const LAS char* ra = wsc + (8 * (lane >> 5) + ((lane & 15) >> 2)) * 64 + (16 * ((lane >> 4) & 1) + 4 * (lane & 3)) * 2;
    const s16x4 lo = __builtin_amdgcn_ds_read_tr16_b64_v4i16((LAS s16x4*)ra);
    const s16x4 hi = __builtin_amdgcn_ds_read_tr16_b64_v4i16((LAS s16x4*)(ra + 4 * 64));
    const s16x8 c = __builtin_shufflevector(lo, hi, 0, 1, 2, 3, 4, 5, 6, 7);
    return __builtin_bit_cast(bf16x8, c);
}
#ifndef PFW2
#define PFW2 4
#endif
#ifndef PFW
#define PFW 4
#endif
struct P4St { WRaw raw[4]; bf16x8 sa[4], sb[4]; };
DI void p4_issue(P4St& S, const float* wb, int loff, const bf16* h2g, const int (&roff)[4]) {
#pragma unroll
    for (int i = 0; i < 4; ++i) S.sa[i] = *(const bf16x8*)(h2g + roff[i]);
#pragma unroll
    for (int q = 0; q < 4; ++q) load_wraw(S.raw[q], wb + (size_t)q * 16 * ED, ED, loff);
#pragma unroll
    for (int i = 0; i < 4; ++i) S.sb[i] = *(const bf16x8*)(h2g + roff[i] + 64);
}
template <int NRT>
DI void p4_chunk(f32x16 (&acc)[NRT], P4St& S, bf16x8& wf, bf16x8 (&snew)[4], const bf16x8 (&swr_regs)[4], int kc, const float* wb, int loff, const bf16* h2g, const int (&roff)[4],
                 LAS char* lds, LAS char* wsc, int swr, int lane, int l31, int h) {
    {
        const int kn = (kc + 2) & 15;
#pragma unroll
        for (int i = 0; i < 4; ++i) snew[i] = *(const bf16x8*)(h2g + roff[i] + 64 * kn);
    }
    const int bcur = kc % 3, bnxt = (kc + 1) % 3;
    const LAS char* ab = lds + L4_ABUF + bcur * (256 * EAP) + l31 * EAP + 16 * h;
#pragma unroll
    for (int s = 0; s < 4; ++s) {
        const int ks = 4 * kc + s;
        const bf16x8 wfn = wfrag_from(S.raw[(s + 1) & 3], wsc, lane);
        load_wraw(S.raw[(s + 1) & 3], wb + (size_t)((ks + 5) & 63) * 16 * ED, ED, loff);
#pragma unroll
        for (int g = 0; g < NRT; g += 4) {
            bf16x8 bt[4];
#pragma unroll
            for (int rt = 0; rt < 4; ++rt) if (g + rt < NRT) bt[rt] = *(const LAS bf16x8*)(ab + (g + rt) * 32 * EAP + 32 * s);
#pragma unroll
            for (int rt = 0; rt < 4; ++rt) if (g + rt < NRT) acc[g + rt] = MFMA32(wf, bt[rt], acc[g + rt]);
        }
        __builtin_amdgcn_sched_barrier(0);
        wf = wfn;
    }
#pragma unroll
    for (int i = 0; i < 4; ++i) *(LAS bf16x8*)(lds + L4_ABUF + bnxt * (256 * EAP) + swr + i * 8 * EAP) = swr_regs[i];
    __syncthreads();
}
template <int NRT>
DI void p4_run(f32x16 (&acc)[NRT], P4St& S, const float* wb, int loff, const bf16* h2g, const int (&roff)[4], LAS char* lds, int wv, int lane, int l31, int h) {
#pragma unroll
    for (int rt = 0; rt < NRT; ++rt)
#pragma unroll
        for (int r = 0; r < 16; ++r) acc[rt][r] = 0.f;
    const int swr = (32 * wv + (lane >> 3)) * EAP + 16 * (lane & 7);
    LAS char* wsc = lds + L4_WSC + wv * WSC_BYTES;
#pragma unroll
    for (int i = 0; i < 4; ++i) *(LAS bf16x8*)(lds + L4_ABUF + swr + i * 8 * EAP) = S.sa[i];
    bf16x8 wf = wfrag_from(S.raw[0], wsc, lane);
    load_wraw(S.raw[0], wb + (size_t)4 * 16 * ED, ED, loff);
    __syncthreads();
#pragma unroll 1
    for (int kc = 0; kc < 16; kc += 2) {
        p4_chunk<NRT>(acc, S, wf, S.sa, S.sb, kc, wb, loff, h2g, roff, lds, wsc, swr, lane, l31, h);
        p4_chunk<NRT>(acc, S, wf, S.sb, S.sa, kc + 1, wb, loff, h2g, roff, lds, wsc, swr, lane, l31, h);
    }
}
template <int NRT>
DI void p4_item(const Params& p, LAS char* lds, int e, int nrows, int wv, int vcu) {
    LAS int* rowasg = (LAS int*)(lds + L4_ROW);
    LAS float* rowgate = (LAS float*)(lds + L4_GATE);
    const int lane = lane_opaque(), h = lane >> 5, l31 = lane & 31;
    bf16x8* dump = (bf16x8*)(p.ws + WS_SG) + (size_t)(vcu * NWAVE + wv) * 16 * 64 + lane;
    const bf16* h2g = (const bf16*)(p.ws + WS_H2);
    int roff[4];
#pragma unroll
    for (int i = 0; i < 4; ++i) roff[i] = (rowasg[32 * wv + 8 * i + (lane >> 3)] >> 3) * DM + 8 * (lane & 7);
    bf16* ybuf = (bf16*)(p.ws + WS_Y);
    f32x16 acc[NRT];
    const int loff1 = (lane >> 3) * ED + 4 * (lane & 7);
    const float* wgb = p.w_gate_e + (size_t)e * DM * ED + 32 * wv;
    const float* wub = p.w_up_e + (size_t)e * DM * ED + 32 * wv;
    P4St S;
    p4_issue(S, wgb, loff1, h2g, roff);
    p4_run<NRT>(acc, S, wgb, loff1, h2g, roff, lds, wv, lane, l31, h);
    p4_issue(S, wub, loff1, h2g, roff);
#pragma unroll
    for (int rt = 0; rt < NRT; ++rt) {
        bf16x8 d0, d1;
#pragma unroll
        for (int j = 0; j < 8; ++j) { d0[j] = (bf16)silu_f(acc[rt][j]); d1[j] = (bf16)silu_f(acc[rt][8 + j]); }
        dump[(2 * rt) * 64] = d0; dump[(2 * rt + 1) * 64] = d1;
        __builtin_amdgcn_sched_barrier(0);
    }
    p4_run<NRT>(acc, S, wub, loff1, h2g, roff, lds, wv, lane, l31, h);
    const int loff2 = (lane_opaque() >> 3) * DM + 4 * (lane_opaque() & 7);
    const float* wdb = p.w_down_e + (size_t)e * ED * DM + 32 * wv;
    WRaw raw[4];
#pragma unroll
    for (int q = 0; q < 4; ++q) load_wraw(raw[q], wdb + (size_t)q * 16 * DM, DM, loff2);
    const bf16x8* dump2 = (const bf16x8*)(p.ws + WS_SG) + (size_t)(vcu * NWAVE + wv) * 16 * 64 + lane_opaque();
#pragma unroll
    for (int rt = 0; rt < NRT; ++rt) {
        const bf16x8 d0 = __builtin_nontemporal_load(&dump2[(2 * rt) * 64]), d1 = __builtin_nontemporal_load(&dump2[(2 * rt + 1) * 64]);
        const float gq = rowgate[32 * rt + l31];
        LAS char* dst = lds + L4_ACT + (32 * rt + l31) * ACTP + (32 * wv + 4 * h) * 2;
#pragma unroll
        for (int g4 = 0; g4 < 4; ++g4) {
            float a[4];
#pragma unroll
            for (int e2 = 0; e2 < 4; ++e2) { const int r = 4 * g4 + e2; a[e2] = (float)(r < 8 ? d0[r] : d1[r - 8]) * acc[rt][r] * gq; }
            *(LAS bf16x4*)(dst + 16 * g4) = pack4(a[0], a[1], a[2], a[3]);
        }
    }
    __syncthreads();
    {
        LAS char* wsc = lds + L4_WSC + wv * WSC_BYTES;
        const LAS char* ab = lds + L4_ACT + l31 * ACTP + 16 * h;
        bf16x8 wf = wfrag_from(raw[0], wsc, lane);
        load_wraw(raw[0], wdb + (size_t)4 * 16 * DM, DM, loff2);
        bf16x8 bt[NRT];
#pragma unroll
        for (int rt = 0; rt < NRT; ++rt) bt[rt] = *(const LAS bf16x8*)(ab + rt * 32 * ACTP);
#pragma unroll 1
        for (int np = 0; np < 4; ++np) {
#pragma unroll
            for (int rt = 0; rt < NRT; ++rt)
#pragma unroll
                for (int r = 0; r < 16; ++r) acc[rt][r] = 0.f;
#pragma unroll 1
            for (int k4 = 0; k4 < 16; k4 += 4) {
#pragma unroll
                for (int q = 0; q < 4; ++q) {
                    const int ks = k4 + q, gn = (16 * np + ks + 5) & 63;
                    const bf16x8 wfn = wfrag_from(raw[(q + 1) & 3], wsc, lane);
                    load_wraw(raw[(q + 1) & 3], wdb + (size_t)(gn & 15) * 16 * DM + 256 * (gn >> 4), DM, loff2);
                    bf16x8 btn[NRT];
#pragma unroll
                    for (int rt = 0; rt < NRT; ++rt) btn[rt] = *(const LAS bf16x8*)(ab + rt * 32 * ACTP + 32 * ((ks + 1) & 15));
                    __builtin_amdgcn_sched_barrier(0);
#pragma unroll
                    for (int rt = 0; rt < NRT; ++rt) acc[rt] = MFMA32(wf, bt[rt], acc[rt]);
                    __builtin_amdgcn_sched_barrier(0);
                    wf = wfn;
#pragma unroll
                    for (int rt = 0; rt < NRT; ++rt) bt[rt] = btn[rt];
                }
            }
            const int n0 = 256 * np + 32 * wv;
            {
                int lo2 = lane; asm volatile("" : "+v"(lo2));
                const int trow = lo2 >> 2, tpc = lo2 & 3;
                LAS char* wt = wsc + (lo2 & 31) * 80 + 8 * (lo2 >> 5);
                const LAS char* rd = wsc + trow * 80 + tpc * 16;
                const LAS char* yo = lds + L4_YOFF + 4 * trow;
                const unsigned colb = (unsigned)(n0 + 8 * tpc) * 2u;
#pragma unroll
                for (int rt = 0; rt < NRT; ++rt) {
#pragma unroll
                    for (int g4 = 0; g4 < 4; ++g4)
                        *(LAS bf16x4*)(wt + 16 * g4) = pack4(acc[rt][4 * g4], acc[rt][4 * g4 + 1], acc[rt][4 * g4 + 2], acc[rt][4 * g4 + 3]);
#pragma unroll
                    for (int j2 = 0; j2 < 2; ++j2) {
                        const bf16x8 v = *(const LAS bf16x8*)(rd + j2 * 16 * 80);
                        const unsigned off = (unsigned)*(const LAS int*)(yo + 4 * (32 * rt + 16 * j2)) + colb;
                        *(bf16x8*)((char*)ybuf + off) = v;
                    }
                    __builtin_amdgcn_sched_barrier(0);
                }
            }
        }
    }
    __syncthreads();
}
constexpr int L4_PFX8 = L4_PFX;
static_assert(8 * 33 * 4 <= 1040 + 0 || true, "");
DI void phase4(const Params& p, LAS char* lds, int vcu, int G, int wid, unsigned* qctr) {
    const int wv = wid_opaque(wid);
    const unsigned* cnt = (const unsigned*)(p.ws + WS_CTL + CTL_CNT);
    LAS int* nchs = (LAS int*)(lds + L4_NCH);
    LAS int* pfx8 = (LAS int*)(lds + L4_WSC);
    pfx8 = (LAS int*)(lds + L4_WSC + 8 * WSC_BYTES);
    LAS int* rowasg = (LAS int*)(lds + L4_ROW);
    LAS float* rowgate = (LAS float*)(lds + L4_GATE);
    volatile LAS int* itemw = (volatile LAS int*)(lds + L4_ITEM);
    {
        const int tid = wv * 64 + lane_opaque();
        if (tid < NE) nchs[tid] = ((int)cnt[tid] + 255) >> 8;
        __syncthreads();
        if (tid < 8 * 33) { const int x = tid / 33, j = tid % 33; int s = 0; for (int i = 0; i < j; ++i) s += nchs[8 * i + x]; pfx8[tid] = s; }
        __syncthreads();
    }
    const int* list = (const int*)(p.ws + WS_LIST);
    const float* gatebuf = (const float*)(p.ws + WS_GATE);
    const int myx = (int)(xb_xcc_id() & 7u);
#pragma unroll 1
    for (int sx = 0; sx < 8; ++sx) {
        const int x = (myx + sx) & 7;
        const int total = __builtin_amdgcn_readfirstlane(pfx8[x * 33 + 32]);
        for (;;) {
            if (wv == 0 && lane_opaque() == 0) itemw[0] = (int)atomicAdd(qctr + 64 * x, 1u);
            __syncthreads();
            const int it = __builtin_amdgcn_readfirstlane(itemw[0]);
            if (it >= total) break;
            int lo = 0, hi = 31;
            while (lo < hi) { const int mid = (lo + hi + 1) >> 1; if (pfx8[x * 33 + mid] <= it) lo = mid; else hi = mid - 1; }
            const int j = __builtin_amdgcn_readfirstlane(lo), e = 8 * j + x, ch = it - __builtin_amdgcn_readfirstlane(pfx8[x * 33 + j]);
            const int ne = __builtin_amdgcn_readfirstlane((int)cnt[e]), nch = __builtin_amdgcn_readfirstlane(nchs[e]);
            const int rpc = (((ne + nch - 1) / nch) + 31) & ~31, r0 = ch * rpc, nrows = min(rpc, ne - r0), nrt = (nrows + 31) >> 5;
            {
                const int tid = wv * 64 + lane_opaque();
                if (tid < 256) { const int a = list[(size_t)e * LCAP + r0 + min(tid, nrows - 1)]; rowasg[tid] = a; rowgate[tid] = gatebuf[a]; ((LAS int*)(lds + L4_YOFF))[tid] = (tid < nrows ? a : NTOK * 8) * (DM * 2); }
            }
            __syncthreads();
            if (nrt <= 4) p4_item<4>(p, lds, e, nrows, wv, vcu);
            else if (nrt <= 6) p4_item<6>(p, lds, e, nrows, wv, vcu);
            else p4_item<8>(p, lds, e, nrows, wv, vcu);
        }
        __syncthreads();
    }
}

DI void phase5(const Params& p, int vcu, int G, int wid) {
    const bf16* ybuf = (const bf16*)(p.ws + WS_Y);
    const int gtid = vcu * NTHR + tid_of(wid), gth = G * NTHR;
    for (int i = gtid; i < NTOK * (DM / 8); i += gth) {
        const int tok = i >> 7, n = (i & 127) * 8, b = tok / SEQ;
        float s[8];
#pragma unroll
        for (int e = 0; e < 8; ++e) s[e] = 0.f;
#pragma unroll
        for (int k = 0; k < 8; ++k) {
            const bf16x8 v = *(const bf16x8*)(ybuf + ((size_t)tok * 8 + k) * DM + n);
#pragma unroll
            for (int e = 0; e < 8; ++e) s[e] += (float)v[e];
        }
        float* op = p.out + (size_t)tok * DM + n;
        f32x4 o0 = *(f32x4*)op, o1 = *(f32x4*)(op + 4);
        const float* gm = (const float*)(p.ws + WS_MODF) + b * 6144 + 5 * DM + n;
        const f32x4 g0 = *(const f32x4*)gm, g1 = *(const f32x4*)(gm + 4);
#pragma unroll
        for (int e = 0; e < 4; ++e) { o0[e] += g0[e] * s[e]; o1[e] += g1[e] * s[4 + e]; }
        *(f32x4*)op = o0; *(f32x4*)(op + 4) = o1;
    }
}

DI int vcu_of(int bx, int G) { return (G % 8 == 0) ? (bx % 8) * (G / 8) + bx / 8 : bx; }
#if FUSED
__global__ void __launch_bounds__(NTHR) mk_fwd(Params p) {
    extern __shared__ __attribute__((aligned(16))) unsigned char lds_raw[];
    LAS char* lds = (LAS char*)lds_raw;
    const int G = gridDim.x, vcu = vcu_of(blockIdx.x, G);
    const int wid = __builtin_amdgcn_readfirstlane((int)threadIdx.x >> 6);
    volatile LAS unsigned* st = (volatile LAS unsigned*)(lds + LDS_BARW);
    if (tid_of(wid) == 0) { st[0] = 0u; st[1] = 0u; }
    __syncthreads();
    XcdBarrier bar = xcd_barrier_post((unsigned*)(p.ws + WS_CTL), st, wid);
    phase0(p, lds, vcu, G, wid);
    xcd_barrier(bar);
    if (REP == 0) { phase0(p, lds, vcu, G, wid); xcd_barrier(bar); }
    phase1(p, lds, vcu, wid);
    xcd_barrier(bar);
    if (REP == 1) { phase1(p, lds, vcu, wid); xcd_barrier(bar); }
    phase2(p, lds, vcu, G, wid);
    xcd_barrier(bar);
    if (REP == 2) { phase2(p, lds, vcu, G, wid); xcd_barrier(bar); }
    phase3(p, lds, vcu, wid);
    xcd_barrier(bar);
    phase4(p, lds, vcu, G, wid, (unsigned*)(p.ws + WS_CTL + CTL_Q));
    xcd_barrier(bar);
    if (REP == 4) { phase4(p, lds, vcu, G, wid, (unsigned*)(p.ws + WS_CTL + CTL_Q + 2048)); xcd_barrier(bar); }
    phase5(p, vcu, G, wid);
}
#else
#define LDSDECL extern __shared__ __attribute__((aligned(16))) unsigned char lds_raw[]; LAS char* lds = (LAS char*)lds_raw; const int G = gridDim.x, vcu = vcu_of(blockIdx.x, G); const int wid = __builtin_amdgcn_readfirstlane((int)threadIdx.x >> 6); (void)lds; (void)vcu;
__global__ void __launch_bounds__(NTHR) k_p0(Params p) { LDSDECL phase0(p, lds, vcu, G, wid); }
__global__ void __launch_bounds__(NTHR) k_p1(Params p) { LDSDECL phase1(p, lds, vcu, wid); }
__global__ void __launch_bounds__(NTHR) k_p2(Params p) { LDSDECL phase2(p, lds, vcu, G, wid); }
__global__ void __launch_bounds__(NTHR) k_p3(Params p) { LDSDECL phase3(p, lds, vcu, wid); }
__global__ void __launch_bounds__(NTHR) k_p4(Params p) { LDSDECL phase4(p, lds, vcu, G, wid, (unsigned*)(p.ws + WS_CTL + CTL_Q)); }
__global__ void __launch_bounds__(NTHR) k_p5(Params p) { LDSDECL phase5(p, vcu, G, wid); }
#endif

extern "C" void kernel_launch(void* const* d_in, const int* in_sizes, int n_in, void* d_out, int out_size, void* d_ws, size_t ws_size, hipStream_t stream) {
    if (n_in != 24 || ws_size < WS_END) { fprintf(stderr, "kernel_launch: unexpected inputs (n_in %d, ws %zu < %zu)\n", n_in, ws_size, (size_t)WS_END); return; }
    Params p{};
    p.x = (const float*)d_in[0]; p.c = (const float*)d_in[1]; p.pos = (const int*)d_in[2];
    p.w_ada = (const float*)d_in[3]; p.b_ada = (const float*)d_in[4]; p.g_mix = (const float*)d_in[5]; p.w_in = (const float*)d_in[6];
    p.g_q_a = (const float*)d_in[7]; p.g_k_a = (const float*)d_in[8]; p.sinks = (const float*)d_in[9]; p.g_q_b = (const float*)d_in[10]; p.g_k_b = (const float*)d_in[11];
    p.g_out_a = (const float*)d_in[12]; p.g_out_b = (const float*)d_in[13]; p.w_out = (const float*)d_in[14]; p.g_ffn = (const float*)d_in[15];
    p.w_router = (const float*)d_in[16]; p.r_bias = (const float*)d_in[17]; p.w_gate_e = (const float*)d_in[18]; p.w_up_e = (const float*)d_in[19]; p.w_down_e = (const float*)d_in[20];
    p.w_gate_s = (const float*)d_in[21]; p.w_up_s = (const float*)d_in[22]; p.w_down_s = (const float*)d_in[23];
    p.out = (float*)d_out; p.ws = (unsigned char*)d_ws;
    hipMemsetAsync((char*)d_ws + WS_CTL, 0, CTL_BYTES, stream);
    const int G = 256;
#if FUSED
    static bool attr_done = false;
    if (!attr_done) { hipFuncSetAttribute((const void*)mk_fwd, hipFuncAttributeMaxDynamicSharedMemorySize, LDS_BYTES); attr_done = true; }
    void* args[] = { &p };
    hipError_t e = hipLaunchCooperativeKernel((const void*)mk_fwd, dim3(G), dim3(NTHR), args, LDS_BYTES, stream);
    if (e != hipSuccess) fprintf(stderr, "cooperative launch failed: %s\n", hipGetErrorString(e));
#else
    static bool attr_done = false;
    if (!attr_done) {
        hipFuncSetAttribute((const void*)k_p0, hipFuncAttributeMaxDynamicSharedMemorySize, LDS_BYTES);
        hipFuncSetAttribute((const void*)k_p1, hipFuncAttributeMaxDynamicSharedMemorySize, LDS_BYTES);
        hipFuncSetAttribute((const void*)k_p2, hipFuncAttributeMaxDynamicSharedMemorySize, LDS_BYTES);
        hipFuncSetAttribute((const void*)k_p3, hipFuncAttributeMaxDynamicSharedMemorySize, LDS_BYTES);
        hipFuncSetAttribute((const void*)k_p4, hipFuncAttributeMaxDynamicSharedMemorySize, LDS_BYTES);
        hipFuncSetAttribute((const void*)k_p5, hipFuncAttributeMaxDynamicSharedMemorySize, LDS_BYTES);
        attr_done = true;
    }
    hipLaunchKernelGGL(k_p0, dim3(G), dim3(NTHR), LDS_BYTES, stream, p);
    hipLaunchKernelGGL(k_p1, dim3(G), dim3(NTHR), LDS_BYTES, stream, p);
    hipLaunchKernelGGL(k_p2, dim3(G), dim3(NTHR), LDS_BYTES, stream, p);
    hipLaunchKernelGGL(k_p3, dim3(G), dim3(NTHR), LDS_BYTES, stream, p);
    hipLaunchKernelGGL(k_p4, dim3(G), dim3(NTHR), LDS_BYTES, stream, p);
    hipLaunchKernelGGL(k_p5, dim3(G), dim3(NTHR), LDS_BYTES, stream, p);
#endif
}
```

```cpp
#include <hip/hip_runtime.h>
#include <stdint.h>
#include <cstdio>

#ifndef FUSED
#define FUSED 1
#endif
#ifndef REP
#define REP -1
#endif

typedef __bf16 bf16;
typedef __attribute__((ext_vector_type(8))) __bf16 bf16x8;
typedef __attribute__((ext_vector_type(4))) __bf16 bf16x4;
typedef __attribute__((ext_vector_type(16))) float f32x16;
typedef __attribute__((ext_vector_type(4))) float f32x4;
typedef __attribute__((ext_vector_type(4))) short s16x4;
typedef __attribute__((ext_vector_type(8))) short s16x8;
#define LAS __attribute__((address_space(3)))
#define DI __device__ __forceinline__
#define MFMA32(a, b, c) __builtin_amdgcn_mfma_f32_32x32x16_bf16((a), (b), (c), 0, 0, 0)

constexpr int NB = 8, SEQ = 2048, DM = 1024, NTOK = NB * SEQ, INW = 2304;
constexpr int KA_OFF = 512, VA_OFF = 640, QB_OFF = 768, KB_OFF = 1280, VB_OFF = 1792;
constexpr int NE = 256, ED = 256, LCAP = NTOK;
constexpr float EPS = 1e-6f;
constexpr int NTHR = 512, NWAVE = 8;
constexpr int PITCH = 2064;
constexpr int LDS_BYTES = 163840;
constexpr int LDS_MISC = 64 * PITCH;
constexpr int LDS_BARW = LDS_BYTES - 16;

constexpr size_t WS_CTL = 0;
constexpr size_t CTL_BYTES = 65536;
constexpr size_t CTL_CNT = 32768;
constexpr size_t CTL_Q = 40960;
constexpr size_t WS_MODP = WS_CTL + CTL_BYTES;
constexpr size_t WS_MODF = WS_MODP + 8ull * 8 * 6144 * 4;
constexpr size_t WS_ROPE = WS_MODF + 8ull * 6144 * 4;
constexpr size_t WS_WIN = WS_ROPE + 2ull * NTOK * 8 * 4;
constexpr size_t WS_WOUT = WS_WIN + (size_t)INW * DM * 2;
constexpr size_t WS_WR = WS_WOUT + (size_t)DM * DM * 2;
constexpr size_t WS_WGS = WS_WR + (size_t)NE * DM * 2;
constexpr size_t WS_WUS = WS_WGS + (size_t)256 * DM * 2;
constexpr size_t WS_WDS = WS_WUS + (size_t)256 * DM * 2;
constexpr size_t WS_QKV = WS_WDS + (size_t)256 * DM * 2;
constexpr size_t WS_OA = WS_QKV + (size_t)NTOK * INW * 2;
constexpr size_t WS_OB = WS_OA + (size_t)NTOK * 512 * 2;
constexpr size_t WS_LSE = WS_OB + 3ull * NTOK * 512 * 2;
constexpr size_t WS_H2 = WS_LSE + 3ull * NTOK * 8 * 4;
constexpr size_t WS_LOG = WS_H2 + (size_t)NTOK * DM * 2;
constexpr size_t WS_GATE = WS_LOG + (size_t)NTOK * NE * 4;
constexpr size_t WS_LIST = WS_GATE + (size_t)NTOK * 8 * 4;
constexpr size_t WS_Y = WS_LIST + (size_t)NE * LCAP * 4;
constexpr size_t WS_SG = WS_Y + ((size_t)NTOK * 8 + 1) * DM * 2;
constexpr size_t WS_END = WS_SG + 256ull * 8 * 16 * 64 * 16;

struct Params {
    const float *x, *c; const int* pos;
    const float *w_ada, *b_ada, *g_mix, *w_in, *g_q_a, *g_k_a, *sinks, *g_q_b, *g_k_b, *g_out_a, *g_out_b, *w_out, *g_ffn, *w_router, *r_bias;
    const float *w_gate_e, *w_up_e, *w_down_e, *w_gate_s, *w_up_s, *w_down_s;
    float* out; unsigned char* ws;
};

DI float shx(float v, int mask, int lane) { return __builtin_bit_cast(float, __builtin_amdgcn_ds_bpermute((lane ^ mask) << 2, __builtin_bit_cast(int, v))); }
DI int shxi(int v, int mask, int lane) { return __builtin_amdgcn_ds_bpermute((lane ^ mask) << 2, v); }
DI float shidx(float v, int src, int lane) { (void)lane; return __builtin_bit_cast(float, __builtin_amdgcn_ds_bpermute(src << 2, __builtin_bit_cast(int, v))); }
DI float wave_sum(float v, int lane) {
#pragma unroll
    for (int o = 1; o < 64; o <<= 1) v += shx(v, o, lane);
    return v;
}
DI int lane_opaque() { int l = (int)__builtin_amdgcn_mbcnt_hi(~0u, __builtin_amdgcn_mbcnt_lo(~0u, 0u)); asm volatile("" : "+v"(l)); return l; }
DI int wid_opaque(int wid) { int w = wid; asm volatile("" : "+s"(w)); return w; }
DI int tid_of(int wid) { return wid_opaque(wid) * 64 + lane_opaque(); }
DI float butterfly32(float (&q)[32], int lane) {
#pragma unroll
    for (int step = 0; step < 5; ++step) {
        const int m = 16 >> step;
        const bool up = (lane & m) != 0;
#pragma unroll
        for (int k = 0; k < m; ++k) { const float a = q[k], b = q[k + m]; const float send = up ? a : b, keep = up ? b : a; q[k] = keep + shx(send, m, lane); }
    }
    return q[0];
}
DI int crow(int r, int h) { return (r & 3) + 8 * (r >> 2) + 4 * h; }
DI float silu_f(float v) { return v * __builtin_amdgcn_rcpf(1.f + __expf(-v)); }
DI float mod_val(const Params& p, int b, int idx) {
    const float* mp = (const float*)(p.ws + WS_MODP);
    float s = p.b_ada[idx];
#pragma unroll
    for (int ks = 0; ks < 8; ++ks) s += mp[(size_t)(ks * 8 + b) * 6144 + idx];
    return s;
}
DI bf16x4 pack4(float a, float b, float c, float d) { bf16x4 v; v[0] = (bf16)a; v[1] = (bf16)b; v[2] = (bf16)c; v[3] = (bf16)d; return v; }

#define XB_TMO      128
#define XB_XCNT(j)  (256  + 64 * (j))
#define XB_XSUB(j)  (1280 + 64 * (j))
#define XB_XGEN(j)  (2304 + 64 * (j))
#define XB_TOP      3328
#define XB_TOPGEN   3392
#define XCD_BAR_WORDS 3456
#define XB_SPIN_CAP (1u << 22)
DI unsigned xb_ld(unsigned* p) { return __hip_atomic_load(p, __ATOMIC_RELAXED, __HIP_MEMORY_SCOPE_AGENT); }
DI unsigned xb_add(unsigned* p, unsigned v) { return __hip_atomic_fetch_add(p, v, __ATOMIC_RELAXED, __HIP_MEMORY_SCOPE_AGENT); }
DI unsigned xb_xcc_id() { return (unsigned)__builtin_amdgcn_s_getreg((3 << 11) | 20) & 0xFu; }
#define XB_SPIN(cond, bar) do { unsigned _sp = 0; while (cond) { __builtin_amdgcn_s_sleep(1); \
    if ((++_sp & 255u) == 0u) { if (xb_ld(&(bar)[XB_TMO])) break; if (_sp > XB_SPIN_CAP) { atomicAdd(&(bar)[XB_TMO], 1u); break; } } } } while (0)
struct XcdBarrier { unsigned* bar; unsigned x; volatile LAS unsigned* st; int wid; };
DI XcdBarrier xcd_barrier_post(unsigned* bar, volatile LAS unsigned* st, int wid) {
    XcdBarrier b; b.bar = bar; b.x = xb_xcc_id(); b.st = st; b.wid = wid;
    if (tid_of(wid) == 0) (void)xb_add(&bar[XB_XCNT(b.x)], 1u);
    return b;
}
DI void xcd_barrier_complete(unsigned* bar, unsigned x, unsigned& nloc, unsigned& nx) {
    const unsigned G = gridDim.x * gridDim.y * gridDim.z;
    unsigned sum, cnt, mine, sp = 0u;
    for (;;) {
        sum = 0u; cnt = 0u; mine = 0u;
#pragma unroll
        for (unsigned j = 0; j < 16; ++j) { const unsigned c = xb_ld(&bar[XB_XCNT(j)]); sum += c; cnt += (c > 0u) ? 1u : 0u; mine = (j == x) ? c : mine; }
        if (sum == G) break;
        __builtin_amdgcn_s_sleep(1);
        if ((++sp & 255u) == 0u) { if (xb_ld(&bar[XB_TMO])) break; if (sp > XB_SPIN_CAP) { atomicAdd(&bar[XB_TMO], 1u); break; } }
    }
    nloc = mine > 0u ? mine : 1u; nx = cnt > 0u ? cnt : 1u;
}
DI void xcd_barrier(const XcdBarrier& b) {
    asm volatile("s_waitcnt vmcnt(0)" ::: "memory");
    __syncthreads();
    if (tid_of(b.wid) == 0) {
        unsigned* bar = b.bar;
        __builtin_amdgcn_s_waitcnt(0);
        unsigned nloc = b.st[0], nx = b.st[1];
        if (nloc == 0u) { xcd_barrier_complete(bar, b.x, nloc, nx); b.st[0] = nloc; b.st[1] = nx; }
        const unsigned old = xb_add(&bar[XB_XSUB(b.x)], 1u);
        const unsigned gen = old / nloc;
        if (old + 1u == (gen + 1u) * nloc) {
            __builtin_amdgcn_fence(__ATOMIC_RELEASE, "agent");
            asm volatile("s_waitcnt vmcnt(0)" ::: "memory");
            const unsigned og = xb_add(&bar[XB_TOP], 1u);
            const unsigned tg = og / nx;
            if (og + 1u == (tg + 1u) * nx) xb_add(&bar[XB_TOPGEN], 1u);
            else XB_SPIN(xb_ld(&bar[XB_TOPGEN]) == tg, bar);
            __builtin_amdgcn_fence(__ATOMIC_ACQUIRE, "agent");
            xb_add(&bar[XB_XGEN(b.x)], 1u);
            asm volatile("s_waitcnt vmcnt(0)" ::: "memory");
        } else {
            XB_SPIN(xb_ld(&bar[XB_XGEN(b.x)]) == gen, bar);
            __builtin_amdgcn_fence(__ATOMIC_ACQUIRE, "agent");
            asm volatile("s_waitcnt vmcnt(0)" ::: "memory");
        }
    }
    __syncthreads();
}

template <int NT, int KS, bool CL = false>
DI void gemm_ct(f32x16 (&acc)[NT][2], const bf16x8* const (&wp)[NT], const LAS char* panel, int pitch, int lane) {
    const LAS char* b0 = panel + (lane & 31) * pitch + (lane >> 5) * 16;
    const LAS char* b1 = b0 + 32 * pitch;
    constexpr int PF = (NT >= 4) ? 2 : 4;
    bf16x8 w[PF][NT];
#pragma unroll
    for (int q = 0; q < PF; ++q)
#pragma unroll
        for (int i = 0; i < NT; ++i) w[q][i] = wp[i][q * 64];
#pragma unroll 1
    for (int ks0 = 0; ks0 < KS; ks0 += PF) {
#pragma unroll
        for (int q = 0; q < PF; ++q) {
            const int ks = ks0 + q;
            bf16x8 a[NT];
#pragma unroll
            for (int i = 0; i < NT; ++i) a[i] = w[q][i];
#pragma unroll
            for (int i = 0; i < NT; ++i) w[q][i] = wp[i][((ks + PF) & (KS - 1)) * 64];
            const bf16x8 t0 = *(const LAS bf16x8*)(b0 + ks * 32);
            const bf16x8 t1 = *(const LAS bf16x8*)(b1 + ks * 32);
#pragma unroll
            for (int i = 0; i < NT; ++i) {
                if (CL) { acc[i][0] = MFMA32(t0, a[i], acc[i][0]); acc[i][1] = MFMA32(t1, a[i], acc[i][1]); }
                else    { acc[i][0] = MFMA32(a[i], t0, acc[i][0]); acc[i][1] = MFMA32(a[i], t1, acc[i][1]); }
            }
            __builtin_amdgcn_sched_barrier(0);
        }
    }
}
template <int NT> DI void zero_acc(f32x16 (&acc)[NT][2]) {
#pragma unroll
    for (int i = 0; i < NT; ++i)
#pragma unroll
        for (int t = 0; t < 2; ++t)
#pragma unroll
            for (int r = 0; r < 16; ++r) acc[i][t][r] = 0.f;
}

DI void convert_sw(const float* W, int K, int N, bf16x8* dst, const float* sa, const float* sb, int gtid, int gthreads, bool il4 = false) {
    const int KS = K / 16, total = (N / 32) * KS * 64;
    for (int pc = gtid; pc < total; pc += gthreads) {
        const int l = pc & 63, ks = (pc >> 6) % KS, nt = (pc >> 6) / KS;
        const int n = il4 ? 128 * (nt >> 2) + 4 * (l & 31) + (nt & 3) : 32 * nt + (l & 31), k0 = 16 * ks + 8 * (l >> 5);
        bf16x8 v;
#pragma unroll
        for (int j = 0; j < 8; ++j) {
            float w = W[(size_t)(k0 + j) * N + n];
            if (sa) { const int k = k0 + j; w *= (k < 512) ? sa[k] : sb[k - 512]; }
            v[j] = (bf16)w;
        }
        dst[pc] = v;
    }
}
DI void phase0(const Params& p, LAS char* lds, int vcu, int G, int wid) {
    const int lane = lane_opaque(), wv = wid_opaque(wid), tid = wv * 64 + lane;
    LAS float* red = (LAS float*)lds;
    for (int it = vcu; it < 96 * 8; it += G) {
        const int cc = it % 96, ks = it / 96;
        float acc[8];
#pragma unroll
        for (int b = 0; b < 8; ++b) acc[b] = 0.f;
        const int n = 64 * cc + lane;
        for (int i = 0; i < 16; ++i) {
            const int k = 128 * ks + 16 * wv + i;
            const float w = p.w_ada[(size_t)k * 6144 + n];
#pragma unroll
            for (int b = 0; b < 8; ++b) acc[b] += silu_f(p.c[b * DM + k]) * w;
        }
#pragma unroll
        for (int b = 0; b < 8; ++b) red[(wv * 8 + b) * 64 + lane] = acc[b];
        __syncthreads();
        {
            const int b = tid >> 6, col = tid & 63;
            float s = 0.f;
#pragma unroll
            for (int w8 = 0; w8 < 8; ++w8) s += red[(w8 * 8 + b) * 64 + col];
            ((float*)(p.ws + WS_MODP))[(size_t)(ks * 8 + b) * 6144 + 64 * cc + col] = s;
        }
        __syncthreads();
    }
    const int gtid = vcu * NTHR + tid, gth = G * NTHR;
    convert_sw(p.w_in, DM, INW, (bf16x8*)(p.ws + WS_WIN), nullptr, nullptr, gtid, gth);
    convert_sw(p.w_out, DM, DM, (bf16x8*)(p.ws + WS_WOUT), p.g_out_a, p.g_out_b, gtid, gth, true);
    convert_sw(p.w_router, DM, NE, (bf16x8*)(p.ws + WS_WR), nullptr, nullptr, gtid, gth);
    convert_sw(p.w_gate_s, DM, 256, (bf16x8*)(p.ws + WS_WGS), nullptr, nullptr, gtid, gth);
    convert_sw(p.w_up_s, DM, 256, (bf16x8*)(p.ws + WS_WUS), nullptr, nullptr, gtid, gth);
    convert_sw(p.w_down_s, 256, DM, (bf16x8*)(p.ws + WS_WDS), nullptr, nullptr, gtid, gth, true);
    float* cosT = (float*)(p.ws + WS_ROPE); float* sinT = cosT + (size_t)NTOK * 8;
    for (int e = gtid; e < NTOK * 8; e += gth) {
        const int t = e >> 3, i = e & 7;
        const float inv = (float)exp2(-(double)i * 0.125 * 18.931568569324174);
        const float ang = (float)p.pos[t] * inv;
        double rev = (double)ang * 0.15915494309189535; rev -= floor(rev);
        cosT[e] = __builtin_amdgcn_cosf((float)rev);
        sinT[e] = __builtin_amdgcn_sinf((float)rev);
    }
}

DI void phase1(const Params& p, LAS char* lds, int wg, int wid) {
    const int lane = lane_opaque(), wv = wid_opaque(wid), tid = wv * 64 + lane;
    const int t0 = wg * 64, b = t0 / SEQ;
    if (tid < 192) { const int idx = (wg & 31) * 192 + tid; ((float*)(p.ws + WS_MODF))[b * 6144 + idx] = mod_val(p, b, idx); }
    {
        float ga[16], sh[16];
#pragma unroll
        for (int j = 0; j < 4; ++j)
#pragma unroll
            for (int e = 0; e < 4; ++e) {
                const int k = 256 * j + 4 * lane + e;
                ga[4 * j + e] = p.g_mix[k] * (1.f + mod_val(p, b, 1 * DM + k));
                sh[4 * j + e] = mod_val(p, b, 0 * DM + k);
            }
#pragma unroll 1
        for (int i = 0; i < 8; ++i) {
            const int row = 8 * wv + i;
            const float* xr = p.x + (size_t)(t0 + row) * DM;
            f32x4 v[4]; float ss = 0.f;
#pragma unroll
            for (int j = 0; j < 4; ++j) { v[j] = *(const f32x4*)(xr + 256 * j + 4 * lane); ss += v[j][0] * v[j][0] + v[j][1] * v[j][1] + v[j][2] * v[j][2] + v[j][3] * v[j][3]; }
            const float rstd = rsqrtf(wave_sum(ss, lane) * (1.f / DM) + EPS);
#pragma unroll
            for (int j = 0; j < 4; ++j) {
                const bf16x4 o = pack4(v[j][0] * rstd * ga[4 * j] + sh[4 * j], v[j][1] * rstd * ga[4 * j + 1] + sh[4 * j + 1],
                                       v[j][2] * rstd * ga[4 * j + 2] + sh[4 * j + 2], v[j][3] * rstd * ga[4 * j + 3] + sh[4 * j + 3]);
                *(LAS bf16x4*)(lds + row * PITCH + (256 * j + 4 * lane) * 2) = o;
            }
        }
    }
    __syncthreads();
    const bf16x8* wsw = (const bf16x8*)(p.ws + WS_WIN);
    const float* cosT = (const float*)(p.ws + WS_ROPE); const float* sinT = cosT + (size_t)NTOK * 8;
    bf16* qkv = (bf16*)(p.ws + WS_QKV);
    const int h = lane >> 5;
#pragma unroll 1
    for (int u = wv; u < 36; u += NWAVE) {
        f32x16 acc[2][2]; zero_acc<2>(acc);
        const bf16x8* wp[2] = { wsw + (size_t)(2 * u) * 64 * 64 + lane, wsw + (size_t)(2 * u + 1) * 64 * 64 + lane };
        gemm_ct<2, 64>(acc, wp, lds, PITCH, lane);
        const float* g = nullptr; float qs = 1.f;
        if (u < 8) { g = p.g_q_a; qs = 0.125f; } else if (u < 10) g = p.g_k_a; else if (u >= 12 && u < 20) { g = p.g_q_b; qs = 0.125f; } else if (u >= 20 && u < 28) g = p.g_k_b;
#pragma unroll
        for (int tt = 0; tt < 2; ++tt) {
            const int tok = t0 + 32 * tt + (lane & 31);
            if (g) {
                float ss = 0.f;
#pragma unroll
                for (int nt = 0; nt < 2; ++nt)
#pragma unroll
                    for (int r = 0; r < 16; ++r) ss += acc[nt][tt][r] * acc[nt][tt][r];
                ss += shx(ss, 32, lane);
                const float rstd = rsqrtf(ss * (1.f / 64.f) + EPS);
#pragma unroll
                for (int nt = 0; nt < 2; ++nt)
#pragma unroll
                    for (int r = 0; r < 16; ++r) acc[nt][tt][r] *= rstd * g[32 * nt + crow(r, h)];
#pragma unroll
                for (int r = 0; r < 4; ++r) {
                    const int i = r + 4 * h;
                    const float cs = cosT[(size_t)tok * 8 + i], sn = sinT[(size_t)tok * 8 + i];
                    const float a1 = acc[0][tt][r], a2 = acc[0][tt][r + 4];
                    acc[0][tt][r] = a1 * cs - a2 * sn; acc[0][tt][r + 4] = a2 * cs + a1 * sn;
                }
            }
#pragma unroll
            for (int nt = 0; nt < 2; ++nt)
#pragma unroll
                for (int g4 = 0; g4 < 4; ++g4) {
                    const bf16x4 o = pack4(acc[nt][tt][4 * g4] * qs, acc[nt][tt][4 * g4 + 1] * qs, acc[nt][tt][4 * g4 + 2] * qs, acc[nt][tt][4 * g4 + 3] * qs);
                    *(bf16x4*)(qkv + (size_t)tok * INW + 64 * u + 32 * nt + 8 * g4 + 4 * h) = o;
                }
        }
    }
}

constexpr int VP = 192;
DI void attn_unit(const Params& p, LAS char* vimg, int u, int lane) {
    const int combo = u & 31, blk = (u >> 5) & 31, b = u >> 10;
    const int h = lane >> 5, l31 = lane & 31;
    int qoff, koff, voff, dil, maxd; float m_init, l_init; bf16* outp; float* lsep = nullptr; int hb;
    if (combo < 8) {
        hb = combo; qoff = 64 * hb; koff = KA_OFF + 64 * (hb >> 2); voff = VA_OFF + 64 * (hb >> 2); dil = 1; maxd = 127;
        m_init = p.sinks[hb]; l_init = 1.f; outp = (bf16*)(p.ws + WS_OA);
    } else {
        const int br = (combo - 8) >> 3; hb = (combo - 8) & 7;
        qoff = QB_OFF + 64 * hb; koff = KB_OFF + 64 * hb; voff = VB_OFF + 64 * hb; dil = (br == 0) ? 1 : (br == 1 ? 4 : 16); maxd = 128;
        m_init = -1e30f; l_init = 0.f; outp = (bf16*)(p.ws + WS_OB) + (size_t)br * NTOK * 512; lsep = (float*)(p.ws + WS_LSE) + (size_t)br * NTOK * 8;
    }
    const int L = SEQ / dil, nb = L / 64, rho = blk / nb, l0 = (blk % nb) * 64;
    const bf16* qkv = (const bf16*)(p.ws + WS_QKV) + (size_t)b * SEQ * INW;
    bf16x8 qf[2][4];
#pragma unroll
    for (int qt = 0; qt < 2; ++qt) {
        const bf16* qp = qkv + (size_t)((l0 + 32 * qt + l31) * dil + rho) * INW + qoff + 8 * h;
#pragma unroll
        for (int s = 0; s < 4; ++s) qf[qt][s] = *(const bf16x8*)(qp + 16 * s);
    }
    f32x16 o[2][2];
#pragma unroll
    for (int dt = 0; dt < 2; ++dt)
#pragma unroll
        for (int qt = 0; qt < 2; ++qt)
#pragma unroll
            for (int r = 0; r < 16; ++r) o[dt][qt][r] = 0.f;
    float mrun[2] = { m_init, m_init }, lrun[2] = { h == 0 ? l_init : 0.f, h == 0 ? l_init : 0.f };
    const float LOG2E = 1.4426950408889634f;
#pragma unroll 1
    for (int kt = 0; kt < 6; ++kt) {
        const int lk0 = l0 - 128 + 32 * kt;
        if (lk0 + 31 < 0) continue;
        bf16x8 kf[4];
        {
            int lk = lk0 + l31; lk = lk < 0 ? 0 : lk;
            const bf16* kp = qkv + (size_t)(lk * dil + rho) * INW + koff + 8 * h;
#pragma unroll
            for (int s = 0; s < 4; ++s) kf[s] = *(const bf16x8*)(kp + 16 * s);
        }
        {
            bf16x8 vr[4];
#pragma unroll
            for (int i = 0; i < 4; ++i) {
                int lk = lk0 + (lane >> 3) + 8 * i; lk = lk < 0 ? 0 : lk;
                vr[i] = *(const bf16x8*)(qkv + (size_t)(lk * dil + rho) * INW + voff + 8 * (lane & 7));
            }
#pragma unroll
            for (int i = 0; i < 4; ++i) *(LAS bf16x8*)(vimg + ((lane >> 3) + 8 * i) * VP + 16 * (lane & 7)) = vr[i];
        }
        bf16x8 vf[2][2];
        {
            const int g1 = (lane >> 4) & 1, q4 = (lane & 15) >> 2, p4 = lane & 3;
#pragma unroll
            for (int dt = 0; dt < 2; ++dt)
#pragma unroll
                for (int s = 0; s < 2; ++s) {
                    const LAS char* a0 = vimg + (16 * s + 4 * h + q4) * VP + (32 * dt + 16 * g1 + 4 * p4) * 2;
                    const s16x4 lo = __builtin_amdgcn_ds_read_tr16_b64_v4i16((LAS s16x4*)a0);
                    const s16x4 hi = __builtin_amdgcn_ds_read_tr16_b64_v4i16((LAS s16x4*)(a0 + 8 * VP));
                    const s16x8 c = __builtin_shufflevector(lo, hi, 0, 1, 2, 3, 4, 5, 6, 7);
                    vf[dt][s] = __builtin_bit_cast(bf16x8, c);
                }
        }
#pragma unroll
        for (int qt = 0; qt < 2; ++qt) {
            if ((qt == 0 && kt == 5) || (qt == 1 && kt == 0)) continue;
            f32x16 sacc;
#pragma unroll
            for (int r = 0; r < 16; ++r) sacc[r] = 0.f;
#pragma unroll
            for (int s = 0; s < 4; ++s) sacc = MFMA32(kf[s], qf[qt][s], sacc);
            const int lq = l0 + 32 * qt + l31;
            float mx = -1e30f;
#pragma unroll
            for (int r = 0; r < 16; ++r) {
                const int lk = lk0 + crow(r, h), d = lq - lk;
                const bool ok = (lk >= 0) && (d >= 0) && (d <= maxd);
                sacc[r] = ok ? sacc[r] : -1e30f;
                mx = fmaxf(mx, sacc[r]);
            }
            mx = fmaxf(mx, shx(mx, 32, lane));
            const float mnew = fmaxf(mrun[qt], mx);
            const float alpha = exp2f((mrun[qt] - mnew) * LOG2E);
            float ps = 0.f;
#pragma unroll
            for (int r = 0; r < 16; ++r) { sacc[r] = exp2f((sacc[r] - mnew) * LOG2E); ps += sacc[r]; }
            lrun[qt] = lrun[qt] * alpha + ps; mrun[qt] = mnew;
#pragma unroll
            for (int dt = 0; dt < 2; ++dt)
#pragma unroll
                for (int r = 0; r < 16; ++r) o[dt][qt][r] *= alpha;
            bf16x8 pf[2];
#pragma unroll
            for (int s = 0; s < 2; ++s)
#pragma unroll
                for (int j = 0; j < 8; ++j) pf[s][j] = (bf16)sacc[8 * s + j];
#pragma unroll
            for (int dt = 0; dt < 2; ++dt)
#pragma unroll
                for (int s = 0; s < 2; ++s) o[dt][qt] = MFMA32(vf[dt][s], pf[s], o[dt][qt]);
        }
    }
#pragma unroll
    for (int qt = 0; qt < 2; ++qt) {
        const float lt = lrun[qt] + shx(lrun[qt], 32, lane);
        const float inv = 1.f / lt;
        const size_t tok = (size_t)b * SEQ + (size_t)(l0 + 32 * qt + l31) * dil + rho;
#pragma unroll
        for (int dt = 0; dt < 2; ++dt)
#pragma unroll
            for (int g4 = 0; g4 < 4; ++g4) {
                const bf16x4 v = pack4(o[dt][qt][4 * g4] * inv, o[dt][qt][4 * g4 + 1] * inv, o[dt][qt][4 * g4 + 2] * inv, o[dt][qt][4 * g4 + 3] * inv);
                *(bf16x4*)(outp + tok * 512 + 64 * hb + 32 * dt + 8 * g4 + 4 * h) = v;
            }
        if (lsep && h == 0) lsep[tok * 8 + hb] = mrun[qt] + logf(lt);
    }
}
DI void phase2(const Params& p, LAS char* lds, int vcu, int G, int wid) {
    const int lane = lane_opaque(), wv = wid_opaque(wid), tid = wv * 64 + lane;
    LAS char* vimg = lds + wv * (32 * VP);
    for (int u = vcu * NWAVE + wv; u < 8192; u += G * NWAVE) attn_unit(p, vimg, u, lane);
}

DI void phase3(const Params& p, LAS char* lds, int wg, int wid) {
    const int lane = lane_opaque(), wv = wid_opaque(wid), tid = wv * 64 + lane, h = lane >> 5, l31 = lane & 31;
    const int t0 = wg * 64, b = t0 / SEQ;
    LAS float* ga_l = (LAS float*)(lds + LDS_MISC + 2048);
    LAS float* hs_l = ga_l + 1024;
    LAS float* sh_l = hs_l + 1024;
    LAS float* gm_l = sh_l + 1024;
    {
        const float* mf = (const float*)(p.ws + WS_MODF) + b * 6144;
        for (int n = tid; n < DM; n += NTHR) { ga_l[n] = mf[2 * DM + n]; hs_l[n] = p.g_ffn[n] * (1.f + mf[4 * DM + n]); sh_l[n] = mf[3 * DM + n]; gm_l[n] = mf[5 * DM + n]; }
    }
    {
        const bf16* oa = (const bf16*)(p.ws + WS_OA); const bf16* ob = (const bf16*)(p.ws + WS_OB); const float* lse = (const float*)(p.ws + WS_LSE);
#pragma unroll 1
        for (int ib = 0; ib < 2; ++ib) {
            bf16x8 d[4][3][2]; float e3[4][3];
#pragma unroll
            for (int i = 0; i < 4; ++i) {
                const size_t tok = t0 + 8 * wv + 4 * ib + i;
                if (h == 0) {
                    d[i][0][0] = *(const bf16x8*)(oa + tok * 512 + 16 * l31); d[i][0][1] = *(const bf16x8*)(oa + tok * 512 + 16 * l31 + 8);
                } else {
                    const int hd = l31 >> 2;
#pragma unroll
                    for (int br = 0; br < 3; ++br) {
                        const bf16* src = ob + (size_t)br * NTOK * 512 + tok * 512 + 16 * l31;
                        d[i][br][0] = *(const bf16x8*)src; d[i][br][1] = *(const bf16x8*)(src + 8);
                        e3[i][br] = lse[(size_t)br * NTOK * 8 + tok * 8 + hd];
                    }
                }
            }
#pragma unroll
            for (int i = 0; i < 4; ++i) {
                const int row = 8 * wv + 4 * ib + i;
                float v[16];
                if (h == 0) {
#pragma unroll
                    for (int j = 0; j < 8; ++j) { v[j] = (float)d[i][0][0][j]; v[8 + j] = (float)d[i][0][1][j]; }
                } else {
                    const float mx = fmaxf(e3[i][0], fmaxf(e3[i][1], e3[i][2]));
                    float w0 = __expf(e3[i][0] - mx), w1 = __expf(e3[i][1] - mx), w2 = __expf(e3[i][2] - mx);
                    const float wi = 1.f / (w0 + w1 + w2); w0 *= wi; w1 *= wi; w2 *= wi;
#pragma unroll
                    for (int j = 0; j < 8; ++j) {
                        v[j] = w0 * (float)d[i][0][0][j] + w1 * (float)d[i][1][0][j] + w2 * (float)d[i][2][0][j];
                        v[8 + j] = w0 * (float)d[i][0][1][j] + w1 * (float)d[i][1][1][j] + w2 * (float)d[i][2][1][j];
                    }
                }
                float ss = 0.f;
#pragma unroll
                for (int j = 0; j < 16; ++j) ss += v[j] * v[j];
#pragma unroll
                for (int o2 = 1; o2 < 32; o2 <<= 1) ss += shx(ss, o2, lane);
                const float rstd = rsqrtf(ss * (1.f / 512.f) + EPS);
                bf16x8 o0, o1;
#pragma unroll
                for (int j = 0; j < 8; ++j) { o0[j] = (bf16)(v[j] * rstd); o1[j] = (bf16)(v[8 + j] * rstd); }
                LAS char* dst = lds + row * PITCH + (512 * h + 16 * l31) * 2;
                *(LAS bf16x8*)dst = o0; *(LAS bf16x8*)(dst + 16) = o1;
            }
        }
    }
    __syncthreads();
    f32x16 x1[4][2]; zero_acc<4>(x1);
    {
        const bf16x8* wsw = (const bf16x8*)(p.ws + WS_WOUT);
        const bf16x8* wp[4];
#pragma unroll
        for (int i = 0; i < 4; ++i) wp[i] = wsw + (size_t)(4 * wv + i) * 64 * 64 + lane;
        gemm_ct<4, 64, true>(x1, wp, lds, PITCH, lane);
    }
    LAS float* ssx = (LAS float*)(lds + LDS_MISC);
    LAS float* rsx = (LAS float*)(lds + LDS_MISC + 18432);
    {
        const int lane = lane_opaque(), h = lane >> 5, l31 = lane & 31, nb = 128 * wv + 4 * l31;
        const f32x4 ga4 = *(const LAS f32x4*)(ga_l + nb);
        float q[32];
#pragma unroll
        for (int tt = 0; tt < 2; ++tt)
#pragma unroll
            for (int r = 0; r < 16; ++r) {
                const size_t tok = t0 + 32 * tt + crow(r, h);
                const f32x4 xv = *(const f32x4*)(p.x + tok * DM + nb);
                f32x4 ov; float ss = 0.f;
#pragma unroll
                for (int e = 0; e < 4; ++e) { const float v = xv[e] + ga4[e] * x1[e][tt][r]; x1[e][tt][r] = v; ov[e] = v; ss += v * v; }
                *(f32x4*)(p.out + tok * DM + nb) = ov;
                q[16 * tt + r] = ss;
                if ((r & 7) == 7) __builtin_amdgcn_sched_barrier(0);
            }
        const float tot = butterfly32(q, lane);
        ssx[wv * 64 + 32 * (l31 >> 4) + crow(l31 & 15, h)] = tot;
    }
    __syncthreads();
    { const int tid2 = wv * 64 + lane_opaque();
      if (tid2 < 64) { float ss = 0.f;
#pragma unroll
        for (int w8 = 0; w8 < 8; ++w8) ss += ssx[w8 * 64 + tid2];
        rsx[tid2] = rsqrtf(ss * (1.f / DM) + EPS); } }
    __syncthreads();
    {
        const int lane = lane_opaque(), h = lane >> 5, l31 = lane & 31, nb = 128 * wv + 4 * l31;
        bf16* h2g = (bf16*)(p.ws + WS_H2);
        const f32x4 hs4 = *(const LAS f32x4*)(hs_l + nb), sh4 = *(const LAS f32x4*)(sh_l + nb);
#pragma unroll
        for (int tt = 0; tt < 2; ++tt)
#pragma unroll
            for (int r = 0; r < 16; ++r) {
                const int row = 32 * tt + crow(r, h); const size_t tok = t0 + row;
                const float rstd = rsx[row];
                const bf16x4 o = pack4(x1[0][tt][r] * rstd * hs4[0] + sh4[0], x1[1][tt][r] * rstd * hs4[1] + sh4[1], x1[2][tt][r] * rstd * hs4[2] + sh4[2], x1[3][tt][r] * rstd * hs4[3] + sh4[3]);
                *(LAS bf16x4*)(lds + row * PITCH + nb * 2) = o;
                *(bf16x4*)(h2g + tok * DM + nb) = o;
                if ((r & 3) == 3) __builtin_amdgcn_sched_barrier(0);
            }
    }
    __syncthreads();
    float* logit = (float*)(p.ws + WS_LOG);
    {
        f32x16 ra[1][2]; zero_acc<1>(ra);
        const bf16x8* wp[1] = { (const bf16x8*)(p.ws + WS_WR) + (size_t)wv * 64 * 64 + lane };
        gemm_ct<1, 64, true>(ra, wp, lds, PITCH, lane);
        const int lane = lane_opaque(), h = lane >> 5, l31 = lane & 31;
#pragma unroll
        for (int tt = 0; tt < 2; ++tt)
#pragma unroll
            for (int r = 0; r < 16; ++r) logit[(size_t)(t0 + 32 * tt + crow(r, h)) * NE + 32 * wv + l31] = ra[0][tt][r];
    }
    f32x16 gu[2][2]; zero_acc<2>(gu);
    {
        const bf16x8* wp[2] = { (const bf16x8*)(p.ws + WS_WGS) + (size_t)wv * 64 * 64 + lane, (const bf16x8*)(p.ws + WS_WUS) + (size_t)wv * 64 * 64 + lane };
        gemm_ct<2, 64, true>(gu, wp, lds, PITCH, lane);
    }
    asm volatile("s_waitcnt vmcnt(0)" ::: "memory");
    __syncthreads();
    constexpr int AP = 528;
    { const int lane = lane_opaque(), h = lane >> 5, l31 = lane & 31;
#pragma unroll
      for (int tt = 0; tt < 2; ++tt)
#pragma unroll
        for (int r = 0; r < 16; ++r)
            *(LAS bf16*)(lds + (32 * tt + crow(r, h)) * AP + (32 * wv + l31) * 2) = (bf16)(silu_f(gu[0][tt][r]) * gu[1][tt][r]); }
    {
        const int lane = lane_opaque(); int t0y = t0; asm volatile("" : "+s"(t0y));
        const int g = lane & 7; const size_t tok = t0y + 8 * wv + (lane >> 3);
        unsigned key[32];
        const float* lp = logit + tok * NE + 32 * g;
        float m1 = -INFINITY, m2 = -INFINITY;
#pragma unroll
        for (int j = 0; j < 8; ++j) {
            const f32x4 v = __builtin_nontemporal_load((const f32x4*)(lp + 4 * j));
            const f32x4 rb = *(const f32x4*)(p.r_bias + 32 * g + 4 * j);
#pragma unroll
            for (int e = 0; e < 4; ++e) {
                const float bv = __builtin_amdgcn_rcpf(1.f + __expf(-v[e])) + rb[e];
                key[4 * j + e] = (__float_as_uint(bv + 1.0f) & 0xFFFFFF00u) | (unsigned)(255 - (32 * g + 4 * j + e));
                const float hi = fmaxf(m1, bv), lo = fminf(m1, bv); m1 = hi; m2 = fmaxf(m2, lo);
            }
        }
        const float gs = m1 + m2;
        int rank = 0;
#pragma unroll
        for (int o2 = 0; o2 < 8; ++o2) { const float og = shidx(gs, (lane & ~7) | o2, lane); rank += (og > gs || (og == gs && o2 < g)) ? 1 : 0; }
        if (rank >= 4) {
#pragma unroll
            for (int j = 0; j < 32; ++j) key[j] = 0u;
        }
        unsigned mykey = 0u;
#pragma unroll 1
        for (int k = 0; k < 8; ++k) {
            unsigned kw = 0u;
#pragma unroll
            for (int j = 0; j < 32; ++j) kw = max(kw, key[j]);
#pragma unroll
            for (int o2 = 1; o2 < 8; o2 <<= 1) kw = max(kw, (unsigned)shxi((int)kw, o2, lane));
#pragma unroll
            for (int j = 0; j < 32; ++j) key[j] = (key[j] == kw) ? 0u : key[j];
            if (k == g) mykey = kw;
        }
        const int myexp = 255 - (int)(mykey & 0xFFu);
        const float myscore = __builtin_amdgcn_rcpf(1.f + __expf(-__builtin_nontemporal_load(logit + tok * NE + myexp)));
        float ssum = myscore;
#pragma unroll
        for (int o2 = 1; o2 < 8; o2 <<= 1) ssum += shx(ssum, o2, lane);
        const float gate = myscore / ssum * 2.5f;
        unsigned* cnt = (unsigned*)(p.ws + WS_CTL + CTL_CNT);
        const unsigned pos = atomicAdd(&cnt[myexp], 1u);
        const int asg = (int)tok * 8 + g;
        ((int*)(p.ws + WS_LIST))[(size_t)myexp * LCAP + pos] = asg;
        ((float*)(p.ws + WS_GATE))[asg] = gate;
    }
    __syncthreads();
    {
        f32x16 yd[4][2]; zero_acc<4>(yd);
        const bf16x8* wsw = (const bf16x8*)(p.ws + WS_WDS);
        const bf16x8* wp[4];
#pragma unroll
        for (int i = 0; i < 4; ++i) wp[i] = wsw + (size_t)(4 * wv + i) * 16 * 64 + lane;
        gemm_ct<4, 16, true>(yd, wp, lds, AP, lane);
        int t0x = t0; asm volatile("" : "+s"(t0x));
        const int lane2 = lane_opaque(), nb2 = 128 * wv + 4 * (lane2 & 31), h2 = lane2 >> 5;
        const f32x4 gm4 = *(const LAS f32x4*)(gm_l + nb2);
#pragma unroll
        for (int tt = 0; tt < 2; ++tt)
#pragma unroll
            for (int r = 0; r < 16; ++r) {
                float* op = p.out + (size_t)(t0x + 32 * tt + crow(r, h2)) * DM + nb2;
                f32x4 ov = *(f32x4*)op;
#pragma unroll
                for (int e = 0; e < 4; ++e) ov[e] += gm4[e] * yd[e][tt][r];
                *(f32x4*)op = ov;
                if ((r & 7) == 7) __builtin_amdgcn_sched_barrier(0);
            }
    }
}

constexpr int EAP = 144;
constexpr int ACTP = 528;
constexpr int L4_ABUF = 0;
constexpr int L4_ACT = 0;
constexpr int L4_ROW = 135168;
constexpr int L4_GATE = L4_ROW + 1024;
constexpr int L4_YOFF = L4_GATE + 1024;
constexpr int L4_NCH = L4_YOFF + 1024;
constexpr int L4_PFX = L4_NCH + 1024;
constexpr int L4_ITEM = L4_PFX + 1040;
constexpr int L4_WSC = 141312;
constexpr int WSC_BYTES = 2560;
static_assert(L4_ITEM + 16 <= L4_WSC && L4_WSC + 8 * WSC_BYTES + 8 * 33 * 4 <= LDS_BARW, "P4 LDS layout");
struct WRaw { f32x4 v[2]; };
DI void load_wraw(WRaw& d, const float* base, int ld, int loff) {
    d.v[0] = *(const f32x4*)(base + loff);
    d.v[1] = *(const f32x4*)(base + (size_t)8 * ld + loff);
}
DI bf16x8 wfrag_from(const WRaw& d, LAS char* wsc, int lane) {
    const int wo = (lane >> 3) * 64 + (lane & 7) * 8;
    *(LAS bf16x4*)(wsc + wo) = pack4(d.v[0][0], d.v[0][1], d.v[0][2], d.v[0][3]);
    *(LAS bf16x4*)(wsc + wo + 512) = pack4(d.v[1][0], d.v[1][1], d.v[1][2], d.v[1][3]);
    const LAS char* ra = wsc + (8 * (lane >> 5) + ((lane & 15) >> 2)) * 64 + (16 * ((lane >> 4) & 1) + 4 * (lane & 3)) * 2;
    const s16x4 lo = __builtin_amdgcn_ds_read_tr16_b64_v4i16((LAS s16x4*)ra);
    const s16x4 hi = __builtin_amdgcn_ds_read_tr16_b64_v4i16((LAS s16x4*)(ra + 4 * 64));
    const s16x8 c = __builtin_shufflevector(lo, hi, 0, 1, 2, 3, 4, 5, 6, 7);
    return __builtin_bit_cast(bf16x8, c);
}
#ifndef PFW2
#define PFW2 4
#endif
#ifndef PFW
#define PFW 4
#endif
struct P4St { WRaw raw[4]; bf16x8 sa[4], sb[4]; };
DI void p4_issue(P4St& S, const float* wb, int loff, const bf16* h2g, const int (&roff)[4]) {
#pragma unroll
    for (int i = 0; i < 4; ++i) S.sa[i] = *(const bf16x8*)(h2g + roff[i]);
#pragma unroll
    for (int q = 0; q < 4; ++q) load_wraw(S.raw[q], wb + (size_t)q * 16 * ED, ED, loff);
#pragma unroll
    for (int i = 0; i < 4; ++i) S.sb[i] = *(const bf16x8*)(h2g + roff[i] + 64);
}
template <int NRT>
DI void p4_chunk(f32x16 (&acc)[NRT], P4St& S, bf16x8& wf, bf16x8 (&snew)[4], const bf16x8 (&swr_regs)[4], int kc, const float* wb, int loff, const bf16* h2g, const int (&roff)[4],
                 LAS char* lds, LAS char* wsc, int swr, int lane, int l31, int h) {
    {
        const int kn = (kc + 2) & 15;
#pragma unroll
        for (int i = 0; i < 4; ++i) snew[i] = *(const bf16x8*)(h2g + roff[i] + 64 * kn);
    }
    const int bcur = kc % 3, bnxt = (kc + 1) % 3;
    const LAS char* ab = lds + L4_ABUF + bcur * (256 * EAP) + l31 * EAP + 16 * h;
#pragma unroll
    for (int s = 0; s < 4; ++s) {
        const int ks = 4 * kc + s;
        const bf16x8 wfn = wfrag_from(S.raw[(s + 1) & 3], wsc, lane);
        load_wraw(S.raw[(s + 1) & 3], wb + (size_t)((ks + 5) & 63) * 16 * ED, ED, loff);
#pragma unroll
        for (int g = 0; g < NRT; g += 4) {
            bf16x8 bt[4];
#pragma unroll
            for (int rt = 0; rt < 4; ++rt) if (g + rt < NRT) bt[rt] = *(const LAS bf16x8*)(ab + (g + rt) * 32 * EAP + 32 * s);
#pragma unroll
            for (int rt = 0; rt < 4; ++rt) if (g + rt < NRT) acc[g + rt] = MFMA32(wf, bt[rt], acc[g + rt]);
        }
        __builtin_amdgcn_sched_barrier(0);
        wf = wfn;
    }
#pragma unroll
    for (int i = 0; i < 4; ++i) *(LAS bf16x8*)(lds + L4_ABUF + bnxt * (256 * EAP) + swr + i * 8 * EAP) = swr_regs[i];
    __syncthreads();
}
template <int NRT>
DI void p4_run(f32x16 (&acc)[NRT], P4St& S, const float* wb, int loff, const bf16* h2g, const int (&roff)[4], LAS char* lds, int wv, int lane, int l31, int h) {
#pragma unroll
    for (int rt = 0; rt < NRT; ++rt)
#pragma unroll
        for (int r = 0; r < 16; ++r) acc[rt][r] = 0.f;
    const int swr = (32 * wv + (lane >> 3)) * EAP + 16 * (lane & 7);
    LAS char* wsc = lds + L4_WSC + wv * WSC_BYTES;
#pragma unroll
    for (int i = 0; i < 4; ++i) *(LAS bf16x8*)(lds + L4_ABUF + swr + i * 8 * EAP) = S.sa[i];
    bf16x8 wf = wfrag_from(S.raw[0], wsc, lane);
    load_wraw(S.raw[0], wb + (size_t)4 * 16 * ED, ED, loff);
    __syncthreads();
#pragma unroll 1
    for (int kc = 0; kc < 16; kc += 2) {
        p4_chunk<NRT>(acc, S, wf, S.sa, S.sb, kc, wb, loff, h2g, roff, lds, wsc, swr, lane, l31, h);
        p4_chunk<NRT>(acc, S, wf, S.sb, S.sa, kc + 1, wb, loff, h2g, roff, lds, wsc, swr, lane, l31, h);
    }
}
template <int NRT>
DI void p4_item(const Params& p, LAS char* lds, int e, int nrows, int wv, int vcu) {
    LAS int* rowasg = (LAS int*)(lds + L4_ROW);
    LAS float* rowgate = (LAS float*)(lds + L4_GATE);
    const int lane = lane_opaque(), h = lane >> 5, l31 = lane & 31;
    bf16x8* dump = (bf16x8*)(p.ws + WS_SG) + (size_t)(vcu * NWAVE + wv) * 16 * 64 + lane;
    const bf16* h2g = (const bf16*)(p.ws + WS_H2);
    int roff[4];
#pragma unroll
    for (int i = 0; i < 4; ++i) roff[i] = (rowasg[32 * wv + 8 * i + (lane >> 3)] >> 3) * DM + 8 * (lane & 7);
    bf16* ybuf = (bf16*)(p.ws + WS_Y);
    f32x16 acc[NRT];
    const int loff1 = (lane >> 3) * ED + 4 * (lane & 7);
    const float* wgb = p.w_gate_e + (size_t)e * DM * ED + 32 * wv;
    const float* wub = p.w_up_e + (size_t)e * DM * ED + 32 * wv;
    P4St S;
    p4_issue(S, wgb, loff1, h2g, roff);
    p4_run<NRT>(acc, S, wgb, loff1, h2g, roff, lds, wv, lane, l31, h);
    p4_issue(S, wub, loff1, h2g, roff);
#pragma unroll
    for (int rt = 0; rt < NRT; ++rt) {
        bf16x8 d0, d1;
#pragma unroll
        for (int j = 0; j < 8; ++j) { d0[j] = (bf16)silu_f(acc[rt][j]); d1[j] = (bf16)silu_f(acc[rt][8 + j]); }
        dump[(2 * rt) * 64] = d0; dump[(2 * rt + 1) * 64] = d1;
        __builtin_amdgcn_sched_barrier(0);
    }
    p4_run<NRT>(acc, S, wub, loff1, h2g, roff, lds, wv, lane, l31, h);
    const int loff2 = (lane_opaque() >> 3) * DM + 4 * (lane_opaque() & 7);
    const float* wdb = p.w_down_e + (size_t)e * ED * DM + 32 * wv;
    WRaw raw[4];
#pragma unroll
    for (int q = 0; q < 4; ++q) load_wraw(raw[q], wdb + (size_t)q * 16 * DM, DM, loff2);
    const bf16x8* dump2 = (const bf16x8*)(p.ws + WS_SG) + (size_t)(vcu * NWAVE + wv) * 16 * 64 + lane_opaque();
#pragma unroll
    for (int rt = 0; rt < NRT; ++rt) {
        const bf16x8 d0 = __builtin_nontemporal_load(&dump2[(2 * rt) * 64]), d1 = __builtin_nontemporal_load(&dump2[(2 * rt + 1) * 64]);
        const float gq = rowgate[32 * rt + l31];
        LAS char* dst = lds + L4_ACT + (32 * rt + l31) * ACTP + (32 * wv + 4 * h) * 2;
#pragma unroll
        for (int g4 = 0; g4 < 4; ++g4) {
            float a[4];
#pragma unroll
            for (int e2 = 0; e2 < 4; ++e2) { const int r = 4 * g4 + e2; a[e2] = (float)(r < 8 ? d0[r] : d1[r - 8]) * acc[rt][r] * gq; }
            *(LAS bf16x4*)(dst + 16 * g4) = pack4(a[0], a[1], a[2], a[3]);
        }
    }
    __syncthreads();
    {
        LAS char* wsc = lds + L4_WSC + wv * WSC_BYTES;
        const LAS char* ab = lds + L4_ACT + l31 * ACTP + 16 * h;
        bf16x8 wf = wfrag_from(raw[0], wsc, lane);
        load_wraw(raw[0], wdb + (size_t)4 * 16 * DM, DM, loff2);
        bf16x8 bt[NRT];
#pragma unroll
        for (int rt = 0; rt < NRT; ++rt) bt[rt] = *(const LAS bf16x8*)(ab + rt * 32 * ACTP);
#pragma unroll 1
        for (int np = 0; np < 4; ++np) {
#pragma unroll
            for (int rt = 0; rt < NRT; ++rt)
#pragma unroll
                for (int r = 0; r < 16; ++r) acc[rt][r] = 0.f;
#pragma unroll 1
            for (int k4 = 0; k4 < 16; k4 += 4) {
#pragma unroll
                for (int q = 0; q < 4; ++q) {
                    const int ks = k4 + q, gn = (16 * np + ks + 5) & 63;
                    const bf16x8 wfn = wfrag_from(raw[(q + 1) & 3], wsc, lane);
                    load_wraw(raw[(q + 1) & 3], wdb + (size_t)(gn & 15) * 16 * DM + 256 * (gn >> 4), DM, loff2);
                    bf16x8 btn[NRT];
#pragma unroll
                    for (int rt = 0; rt < NRT; ++rt) btn[rt] = *(const LAS bf16x8*)(ab + rt * 32 * ACTP + 32 * ((ks + 1) & 15));
                    __builtin_amdgcn_sched_barrier(0);
#pragma unroll
                    for (int rt = 0; rt < NRT; ++rt) acc[rt] = MFMA32(wf, bt[rt], acc[rt]);
                    __builtin_amdgcn_sched_barrier(0);
                    wf = wfn;
#pragma unroll
                    for (int rt = 0; rt < NRT; ++rt) bt[rt] = btn[rt];
                }
            }
            const int n0 = 256 * np + 32 * wv;
            {
                int lo2 = lane; asm volatile("" : "+v"(lo2));
                const int trow = lo2 >> 2, tpc = lo2 & 3;
                LAS char* wt = wsc + (lo2 & 31) * 80 + 8 * (lo2 >> 5);
                const LAS char* rd = wsc + trow * 80 + tpc * 16;
                const LAS char* yo = lds + L4_YOFF + 4 * trow;
                const unsigned colb = (unsigned)(n0 + 8 * tpc) * 2u;
#pragma unroll
                for (int rt = 0; rt < NRT; ++rt) {
#pragma unroll
                    for (int g4 = 0; g4 < 4; ++g4)
                        *(LAS bf16x4*)(wt + 16 * g4) = pack4(acc[rt][4 * g4], acc[rt][4 * g4 + 1], acc[rt][4 * g4 + 2], acc[rt][4 * g4 + 3]);
#pragma unroll
                    for (int j2 = 0; j2 < 2; ++j2) {
                        const bf16x8 v = *(const LAS bf16x8*)(rd + j2 * 16 * 80);
                        const unsigned off = (unsigned)*(const LAS int*)(yo + 4 * (32 * rt + 16 * j2)) + colb;
                        *(bf16x8*)((char*)ybuf + off) = v;
                    }
                    __builtin_amdgcn_sched_barrier(0);
                }
            }
        }
    }
    __syncthreads();
}
constexpr int L4_PFX8 = L4_PFX;
static_assert(8 * 33 * 4 <= 1040 + 0 || true, "");
DI void phase4(const Params& p, LAS char* lds, int vcu, int G, int wid, unsigned* qctr) {
    const int wv = wid_opaque(wid);
    const unsigned* cnt = (const unsigned*)(p.ws + WS_CTL + CTL_CNT);
    LAS int* nchs = (LAS int*)(lds + L4_NCH);
    LAS int* pfx8 = (LAS int*)(lds + L4_WSC);
    pfx8 = (LAS int*)(lds + L4_WSC + 8 * WSC_BYTES);
    LAS int* rowasg = (LAS int*)(lds + L4_ROW);
    LAS float* rowgate = (LAS float*)(lds + L4_GATE);
    volatile LAS int* itemw = (volatile LAS int*)(lds + L4_ITEM);
    LAS int* ord8 = (LAS int*)(lds + L4_PFX);
    {
        const int tid = wv * 64 + lane_opaque();
        LAS int* rpcs = (LAS int*)(lds + L4_WSC);
        if (tid < NE) { const int ne = (int)cnt[tid], nch = (ne + 255) >> 8; nchs[tid] = nch; rpcs[tid] = nch ? ((((ne + nch - 1) / nch) + 31) & ~31) : 0; }
        __syncthreads();
        if (tid < NE) {
            const int x = tid & 7, j = tid >> 3, mine = rpcs[tid];
            int rank = 0;
            for (int j2 = 0; j2 < 32; ++j2) { const int o = rpcs[8 * j2 + x]; rank += (o > mine || (o == mine && j2 < j)) ? 1 : 0; }
            ord8[x * 32 + rank] = j;
        }
        __syncthreads();
        if (tid < 8 * 33) { const int x = tid / 33, r = tid % 33; int s = 0; for (int i = 0; i < r; ++i) s += nchs[8 * ord8[x * 32 + i] + x]; pfx8[tid] = s; }
        __syncthreads();
    }
    const int* list = (const int*)(p.ws + WS_LIST);
    const float* gatebuf = (const float*)(p.ws + WS_GATE);
    const int myx = (int)(xb_xcc_id() & 7u);
#pragma unroll 1
    for (int sx = 0; sx < 8; ++sx) {
        const int x = (myx + sx) & 7;
        const int total = __builtin_amdgcn_readfirstlane(pfx8[x * 33 + 32]);
        for (;;) {
            if (wv == 0 && lane_opaque() == 0) itemw[0] = (int)atomicAdd(qctr + 64 * x, 1u);
            __syncthreads();
            const int it = __builtin_amdgcn_readfirstlane(itemw[0]);
            if (it >= total) break;
            int lo = 0, hi = 31;
            while (lo < hi) { const int mid = (lo + hi + 1) >> 1; if (pfx8[x * 33 + mid] <= it) lo = mid; else hi = mid - 1; }
            const int rk = __builtin_amdgcn_readfirstlane(lo), j = __builtin_amdgcn_readfirstlane(ord8[x * 32 + rk]), e = 8 * j + x, ch = it - __builtin_amdgcn_readfirstlane(pfx8[x * 33 + rk]);
            const int ne = __builtin_amdgcn_readfirstlane((int)cnt[e]), nch = __builtin_amdgcn_readfirstlane(nchs[e]);
            const int rpc = (((ne + nch - 1) / nch) + 31) & ~31, r0 = ch * rpc, nrows = min(rpc, ne - r0), nrt = (nrows + 31) >> 5;
            {
                const int tid = wv * 64 + lane_opaque();
                if (tid < 256) { const int a = list[(size_t)e * LCAP + r0 + min(tid, nrows - 1)]; rowasg[tid] = a; rowgate[tid] = gatebuf[a]; ((LAS int*)(lds + L4_YOFF))[tid] = (tid < nrows ? a : NTOK * 8) * (DM * 2); }
            }
            __syncthreads();
            if (nrt <= 4) p4_item<4>(p, lds, e, nrows, wv, vcu);
            else if (nrt <= 6) p4_item<6>(p, lds, e, nrows, wv, vcu);
            else p4_item<8>(p, lds, e, nrows, wv, vcu);
        }
        __syncthreads();
    }
}

DI void phase5(const Params& p, int vcu, int G, int wid) {
    const bf16* ybuf = (const bf16*)(p.ws + WS_Y);
    const int gtid = vcu * NTHR + tid_of(wid), gth = G * NTHR;
    for (int i = gtid; i < NTOK * (DM / 8); i += gth) {
        const int tok = i >> 7, n = (i & 127) * 8, b = tok / SEQ;
        float s[8];
#pragma unroll
        for (int e = 0; e < 8; ++e) s[e] = 0.f;
#pragma unroll
        for (int k = 0; k < 8; ++k) {
            const bf16x8 v = *(const bf16x8*)(ybuf + ((size_t)tok * 8 + k) * DM + n);
#pragma unroll
            for (int e = 0; e < 8; ++e) s[e] += (float)v[e];
        }
        float* op = p.out + (size_t)tok * DM + n;
        f32x4 o0 = *(f32x4*)op, o1 = *(f32x4*)(op + 4);
        const float* gm = (const float*)(p.ws + WS_MODF) + b * 6144 + 5 * DM + n;
        const f32x4 g0 = *(const f32x4*)gm, g1 = *(const f32x4*)(gm + 4);
#pragma unroll
        for (int e = 0; e < 4; ++e) { o0[e] += g0[e] * s[e]; o1[e] += g1[e] * s[4 + e]; }
        *(f32x4*)op = o0; *(f32x4*)(op + 4) = o1;
    }
}

DI int vcu_of(int bx, int G) { return (G % 8 == 0) ? (bx % 8) * (G / 8) + bx / 8 : bx; }
#if FUSED
__global__ void __launch_bounds__(NTHR) mk_fwd(Params p) {
    extern __shared__ __attribute__((aligned(16))) unsigned char lds_raw[];
    LAS char* lds = (LAS char*)lds_raw;
    const int G = gridDim.x, vcu = vcu_of(blockIdx.x, G);
    const int wid = __builtin_amdgcn_readfirstlane((int)threadIdx.x >> 6);
    volatile LAS unsigned* st = (volatile LAS unsigned*)(lds + LDS_BARW);
    if (tid_of(wid) == 0) { st[0] = 0u; st[1] = 0u; }
    __syncthreads();
    XcdBarrier bar = xcd_barrier_post((unsigned*)(p.ws + WS_CTL), st, wid);
    phase0(p, lds, vcu, G, wid);
    xcd_barrier(bar);
    if (REP == 0) { phase0(p, lds, vcu, G, wid); xcd_barrier(bar); }
    phase1(p, lds, vcu, wid);
    xcd_barrier(bar);
    if (REP == 1) { phase1(p, lds, vcu, wid); xcd_barrier(bar); }
    phase2(p, lds, vcu, G, wid);
    xcd_barrier(bar);
    if (REP == 2) { phase2(p, lds, vcu, G, wid); xcd_barrier(bar); }
    phase3(p, lds, vcu, wid);
    xcd_barrier(bar);
    phase4(p, lds, vcu, G, wid, (unsigned*)(p.ws + WS_CTL + CTL_Q));
    xcd_barrier(bar);
    if (REP == 4) { phase4(p, lds, vcu, G, wid, (unsigned*)(p.ws + WS_CTL + CTL_Q + 2048)); xcd_barrier(bar); }
    phase5(p, vcu, G, wid);
}
#else
#define LDSDECL extern __shared__ __attribute__((aligned(16))) unsigned char lds_raw[]; LAS char* lds = (LAS char*)lds_raw; const int G = gridDim.x, vcu = vcu_of(blockIdx.x, G); const int wid = __builtin_amdgcn_readfirstlane((int)threadIdx.x >> 6); (void)lds; (void)vcu;
__global__ void __launch_bounds__(NTHR) k_p0(Params p) { LDSDECL phase0(p, lds, vcu, G, wid); }
__global__ void __launch_bounds__(NTHR) k_p1(Params p) { LDSDECL phase1(p, lds, vcu, wid); }
__global__ void __launch_bounds__(NTHR) k_p2(Params p) { LDSDECL phase2(p, lds, vcu, G, wid); }
__global__ void __launch_bounds__(NTHR) k_p3(Params p) { LDSDECL phase3(p, lds, vcu, wid); }
__global__ void __launch_bounds__(NTHR) k_p4(Params p) { LDSDECL phase4(p, lds, vcu, G, wid, (unsigned*)(p.ws + WS_CTL + CTL_Q)); }
__global__ void __launch_bounds__(NTHR) k_p5(Params p) { LDSDECL phase5(p, vcu, G, wid); }
#endif

extern "C" void kernel_launch(void* const* d_in, const int* in_sizes, int n_in, void* d_out, int out_size, void* d_ws, size_t ws_size, hipStream_t stream) {
    if (n_in != 24 || ws_size < WS_END) { fprintf(stderr, "kernel_launch: unexpected inputs (n_in %d, ws %zu < %zu)\n", n_in, ws_size, (size_t)WS_END); return; }
    Params p{};
    p.x = (const float*)d_in[0]; p.c = (const float*)d_in[1]; p.pos = (const int*)d_in[2];
    p.w_ada = (const float*)d_in[3]; p.b_ada = (const float*)d_in[4]; p.g_mix = (const float*)d_in[5]; p.w_in = (const float*)d_in[6];
    p.g_q_a = (const float*)d_in[7]; p.g_k_a = (const float*)d_in[8]; p.sinks = (const float*)d_in[9]; p.g_q_b = (const float*)d_in[10]; p.g_k_b = (const float*)d_in[11];
    p.g_out_a = (const float*)d_in[12]; p.g_out_b = (const float*)d_in[13]; p.w_out = (const float*)d_in[14]; p.g_ffn = (const float*)d_in[15];
    p.w_router = (const float*)d_in[16]; p.r_bias = (const float*)d_in[17]; p.w_gate_e = (const float*)d_in[18]; p.w_up_e = (const float*)d_in[19]; p.w_down_e = (const float*)d_in[20];
    p.w_gate_s = (const float*)d_in[21]; p.w_up_s = (const float*)d_in[22]; p.w_down_s = (const float*)d_in[23];
    p.out = (float*)d_out; p.ws = (unsigned char*)d_ws;
    hipMemsetAsync((char*)d_ws + WS_CTL, 0, CTL_BYTES, stream);
    const int G = 256;
#if FUSED
    static bool attr_done = false;
    if (!attr_done) { hipFuncSetAttribute((const void*)mk_fwd, hipFuncAttributeMaxDynamicSharedMemorySize, LDS_BYTES); attr_done = true; }
    void* args[] = { &p };
    hipError_t e = hipLaunchCooperativeKernel((const void*)mk_fwd, dim3(G), dim3(NTHR), args, LDS_BYTES, stream);
    if (e != hipSuccess) fprintf(stderr, "cooperative launch failed: %s\n", hipGetErrorString(e));
#else
    static bool attr_done = false;
    if (!attr_done) {
        hipFuncSetAttribute((const void*)k_p0, hipFuncAttributeMaxDynamicSharedMemorySize, LDS_BYTES);
        hipFuncSetAttribute((const void*)k_p1, hipFuncAttributeMaxDynamicSharedMemorySize, LDS_BYTES);
        hipFuncSetAttribute((const void*)k_p2, hipFuncAttributeMaxDynamicSharedMemorySize, LDS_BYTES);
        hipFuncSetAttribute((const void*)k_p3, hipFuncAttributeMaxDynamicSharedMemorySize, LDS_BYTES);
        hipFuncSetAttribute((const void*)k_p4, hipFuncAttributeMaxDynamicSharedMemorySize, LDS_BYTES);
        hipFuncSetAttribute((const void*)k_p5, hipFuncAttributeMaxDynamicSharedMemorySize, LDS_BYTES);
        attr_done = true;
    }
    hipLaunchKernelGGL(k_p0, dim3(G), dim3(NTHR), LDS_BYTES, stream, p);
    hipLaunchKernelGGL(k_p1, dim3(G), dim3(NTHR), LDS_BYTES, stream, p);
    hipLaunchKernelGGL(k_p2, dim3(G), dim3(NTHR), LDS_BYTES, stream, p);
    hipLaunchKernelGGL(k_p3, dim3(G), dim3(NTHR), LDS_BYTES, stream, p);
    hipLaunchKernelGGL(k_p4, dim3(G), dim3(NTHR), LDS_BYTES, stream, p);
    hipLaunchKernelGGL(k_p5, dim3(G), dim3(NTHR), LDS_BYTES, stream, p);
#endif
}
```

```cpp
#include <hip/hip_runtime.h>
#include <stdint.h>
#include <cstdio>

#ifndef FUSED
#define FUSED 1
#endif
#ifndef REP
#define REP -1
#endif

typedef __bf16 bf16;
typedef __attribute__((ext_vector_type(8))) __bf16 bf16x8;
typedef __attribute__((ext_vector_type(4))) __bf16 bf16x4;
typedef __attribute__((ext_vector_type(16))) float f32x16;
typedef __attribute__((ext_vector_type(4))) float f32x4;
typedef __attribute__((ext_vector_type(4))) short s16x4;
typedef __attribute__((ext_vector_type(8))) short s16x8;
#define LAS __attribute__((address_space(3)))
#define DI __device__ __forceinline__
#define MFMA32(a, b, c) __builtin_amdgcn_mfma_f32_32x32x16_bf16((a), (b), (c), 0, 0, 0)

constexpr int NB = 8, SEQ = 2048, DM = 1024, NTOK = NB * SEQ, INW = 2304;
constexpr int KA_OFF = 512, VA_OFF = 640, QB_OFF = 768, KB_OFF = 1280, VB_OFF = 1792;
constexpr int NE = 256, ED = 256, LCAP = NTOK;
constexpr float EPS = 1e-6f;
constexpr int NTHR = 512, NWAVE = 8;
constexpr int PITCH = 2064;
constexpr int LDS_BYTES = 163840;
constexpr int LDS_MISC = 64 * PITCH;
constexpr int LDS_BARW = LDS_BYTES - 16;

constexpr size_t WS_CTL = 0;
constexpr size_t CTL_BYTES = 65536;
constexpr size_t CTL_CNT = 32768;
constexpr size_t CTL_Q = 40960;
constexpr size_t WS_MODP = WS_CTL + CTL_BYTES;
constexpr size_t WS_MODF = WS_MODP + 8ull * 8 * 6144 * 4;
constexpr size_t WS_ROPE = WS_MODF + 8ull * 6144 * 4;
constexpr size_t WS_WIN = WS_ROPE + 2ull * NTOK * 8 * 4;
constexpr size_t WS_WOUT = WS_WIN + (size_t)INW * DM * 2;
constexpr size_t WS_WR = WS_WOUT + (size_t)DM * DM * 2;
constexpr size_t WS_WGS = WS_WR + (size_t)NE * DM * 2;
constexpr size_t WS_WUS = WS_WGS + (size_t)256 * DM * 2;
constexpr size_t WS_WDS = WS_WUS + (size_t)256 * DM * 2;
constexpr size_t WS_QKV = WS_WDS + (size_t)256 * DM * 2;
constexpr size_t WS_OA = WS_QKV + (size_t)NTOK * INW * 2;
constexpr size_t WS_OB = WS_OA + (size_t)NTOK * 512 * 2;
constexpr size_t WS_LSE = WS_OB + 3ull * NTOK * 512 * 2;
constexpr size_t WS_H2 = WS_LSE + 3ull * NTOK * 8 * 4;
constexpr size_t WS_LOG = WS_H2 + (size_t)NTOK * DM * 2;
constexpr size_t WS_GATE = WS_LOG + (size_t)NTOK * NE * 4;
constexpr size_t WS_LIST = WS_GATE + (size_t)NTOK * 8 * 4;
constexpr size_t WS_Y = WS_LIST + (size_t)NE * LCAP * 4;
constexpr size_t WS_SG = WS_Y + ((size_t)NTOK * 8 + 1) * DM * 2;
constexpr size_t WS_END = WS_SG + 256ull * 8 * 16 * 64 * 16;

struct Params {
    const float *x, *c; const int* pos;
    const float *w_ada, *b_ada, *g_mix, *w_in, *g_q_a, *g_k_a, *sinks, *g_q_b, *g_k_b, *g_out_a, *g_out_b, *w_out, *g_ffn, *w_router, *r_bias;
    const float *w_gate_e, *w_up_e, *w_down_e, *w_gate_s, *w_up_s, *w_down_s;
    float* out; unsigned char* ws;
};

DI float shx(float v, int mask, int lane) { return __builtin_bit_cast(float, __builtin_amdgcn_ds_bpermute((lane ^ mask) << 2, __builtin_bit_cast(int, v))); }
DI int shxi(int v, int mask, int lane) { return __builtin_amdgcn_ds_bpermute((lane ^ mask) << 2, v); }
DI float shidx(float v, int src, int lane) { (void)lane; return __builtin_bit_cast(float, __builtin_amdgcn_ds_bpermute(src << 2, __builtin_bit_cast(int, v))); }
DI float wave_sum(float v, int lane) {
#pragma unroll
    for (int o = 1; o < 64; o <<= 1) v += shx(v, o, lane);
    return v;
}
DI int lane_opaque() { int l = (int)__builtin_amdgcn_mbcnt_hi(~0u, __builtin_amdgcn_mbcnt_lo(~0u, 0u)); asm volatile("" : "+v"(l)); return l; }
DI int wid_opaque(int wid) { int w = wid; asm volatile("" : "+s"(w)); return w; }
DI int tid_of(int wid) { return wid_opaque(wid) * 64 + lane_opaque(); }
DI float butterfly32(float (&q)[32], int lane) {
#pragma unroll
    for (int step = 0; step < 5; ++step) {
        const int m = 16 >> step;
        const bool up = (lane & m) != 0;
#pragma unroll
        for (int k = 0; k < m; ++k) { const float a = q[k], b = q[k + m]; const float send = up ? a : b, keep = up ? b : a; q[k] = keep + shx(send, m, lane); }
    }
    return q[0];
}
DI int crow(int r, int h) { return (r & 3) + 8 * (r >> 2) + 4 * h; }
DI float silu_f(float v) { return v * __builtin_amdgcn_rcpf(1.f + __expf(-v)); }
DI float mod_val(const Params& p, int b, int idx) {
    const float* mp = (const float*)(p.ws + WS_MODP);
    float s = p.b_ada[idx];
#pragma unroll
    for (int ks = 0; ks < 8; ++ks) s += mp[(size_t)(ks * 8 + b) * 6144 + idx];
    return s;
}
DI bf16x4 pack4(float a, float b, float c, float d) { bf16x4 v; v[0] = (bf16)a; v[1] = (bf16)b; v[2] = (bf16)c; v[3] = (bf16)d; return v; }

#define XB_TMO      128
#define XB_XCNT(j)  (256  + 64 * (j))
#define XB_XSUB(j)  (1280 + 64 * (j))
#define XB_XGEN(j)  (2304 + 64 * (j))
#define XB_TOP      3328
#define XB_TOPGEN   3392
#define XCD_BAR_WORDS 3456
#define XB_SPIN_CAP (1u << 22)
DI unsigned xb_ld(unsigned* p) { return __hip_atomic_load(p, __ATOMIC_RELAXED, __HIP_MEMORY_SCOPE_AGENT); }
DI unsigned xb_add(unsigned* p, unsigned v) { return __hip_atomic_fetch_add(p, v, __ATOMIC_RELAXED, __HIP_MEMORY_SCOPE_AGENT); }
DI unsigned xb_xcc_id() { return (unsigned)__builtin_amdgcn_s_getreg((3 << 11) | 20) & 0xFu; }
#define XB_SPIN(cond, bar) do { unsigned _sp = 0; while (cond) { __builtin_amdgcn_s_sleep(1); \
    if ((++_sp & 255u) == 0u) { if (xb_ld(&(bar)[XB_TMO])) break; if (_sp > XB_SPIN_CAP) { atomicAdd(&(bar)[XB_TMO], 1u); break; } } } } while (0)
struct XcdBarrier { unsigned* bar; unsigned x; volatile LAS unsigned* st; int wid; };
DI XcdBarrier xcd_barrier_post(unsigned* bar, volatile LAS unsigned* st, int wid) {
    XcdBarrier b; b.bar = bar; b.x = xb_xcc_id(); b.st = st; b.wid = wid;
    if (tid_of(wid) == 0) (void)xb_add(&bar[XB_XCNT(b.x)], 1u);
    return b;
}
DI void xcd_barrier_complete(unsigned* bar, unsigned x, unsigned& nloc, unsigned& nx) {
    const unsigned G = gridDim.x * gridDim.y * gridDim.z;
    unsigned sum, cnt, mine, sp = 0u;
    for (;;) {
        sum = 0u; cnt = 0u; mine = 0u;
#pragma unroll
        for (unsigned j = 0; j < 16; ++j) { const unsigned c = xb_ld(&bar[XB_XCNT(j)]); sum += c; cnt += (c > 0u) ? 1u : 0u; mine = (j == x) ? c : mine; }
        if (sum == G) break;
        __builtin_amdgcn_s_sleep(1);
        if ((++sp & 255u) == 0u) { if (xb_ld(&bar[XB_TMO])) break; if (sp > XB_SPIN_CAP) { atomicAdd(&bar[XB_TMO], 1u); break; } }
    }
    nloc = mine > 0u ? mine : 1u; nx = cnt > 0u ? cnt : 1u;
}
DI void xcd_barrier(const XcdBarrier& b) {
    asm volatile("s_waitcnt vmcnt(0)" ::: "memory");
    __syncthreads();
    if (tid_of(b.wid) == 0) {
        unsigned* bar = b.bar;
        __builtin_amdgcn_s_waitcnt(0);
        unsigned nloc = b.st[0], nx = b.st[1];
        if (nloc == 0u) { xcd_barrier_complete(bar, b.x, nloc, nx); b.st[0] = nloc; b.st[1] = nx; }
        const unsigned old = xb_add(&bar[XB_XSUB(b.x)], 1u);
        const unsigned gen = old / nloc;
        if (old + 1u == (gen + 1u) * nloc) {
            __builtin_amdgcn_fence(__ATOMIC_RELEASE, "agent");
            asm volatile("s_waitcnt vmcnt(0)" ::: "memory");
            const unsigned og = xb_add(&bar[XB_TOP], 1u);
            const unsigned tg = og / nx;
            if (og + 1u == (tg + 1u) * nx) xb_add(&bar[XB_TOPGEN], 1u);
            else XB_SPIN(xb_ld(&bar[XB_TOPGEN]) == tg, bar);
            __builtin_amdgcn_fence(__ATOMIC_ACQUIRE, "agent");
            xb_add(&bar[XB_XGEN(b.x)], 1u);
            asm volatile("s_waitcnt vmcnt(0)" ::: "memory");
        } else {
            XB_SPIN(xb_ld(&bar[XB_XGEN(b.x)]) == gen, bar);
            __builtin_amdgcn_fence(__ATOMIC_ACQUIRE, "agent");
            asm volatile("s_waitcnt vmcnt(0)" ::: "memory");
        }
    }
    __syncthreads();
}

template <int NT, int KS, bool CL = false>
DI void gemm_ct(f32x16 (&acc)[NT][2], const bf16x8* const (&wp)[NT], const LAS char* panel, int pitch, int lane) {
    const LAS char* b0 = panel + (lane & 31) * pitch + (lane >> 5) * 16;
    const LAS char* b1 = b0 + 32 * pitch;
    constexpr int PF = (NT >= 4) ? 2 : 4;
    bf16x8 w[PF][NT];
#pragma unroll
    for (int q = 0; q < PF; ++q)
#pragma unroll
        for (int i = 0; i < NT; ++i) w[q][i] = wp[i][q * 64];
#pragma unroll 1
    for (int ks0 = 0; ks0 < KS; ks0 += PF) {
#pragma unroll
        for (int q = 0; q < PF; ++q) {
            const int ks = ks0 + q;
            bf16x8 a[NT];
#pragma unroll
            for (int i = 0; i < NT; ++i) a[i] = w[q][i];
#pragma unroll
            for (int i = 0; i < NT; ++i) w[q][i] = wp[i][((ks + PF) & (KS - 1)) * 64];
            const bf16x8 t0 = *(const LAS bf16x8*)(b0 + ks * 32);
            const bf16x8 t1 = *(const LAS bf16x8*)(b1 + ks * 32);
#pragma unroll
            for (int i = 0; i < NT; ++i) {
                if (CL) { acc[i][0] = MFMA32(t0, a[i], acc[i][0]); acc[i][1] = MFMA32(t1, a[i], acc[i][1]); }
                else    { acc[i][0] = MFMA32(a[i], t0, acc[i][0]); acc[i][1] = MFMA32(a[i], t1, acc[i][1]); }
            }
            __builtin_amdgcn_sched_barrier(0);
        }
    }
}
template <int NT> DI void zero_acc(f32x16 (&acc)[NT][2]) {
#pragma unroll
    for (int i = 0; i < NT; ++i)
#pragma unroll
        for (int t = 0; t < 2; ++t)
#pragma unroll
            for (int r = 0; r < 16; ++r) acc[i][t][r] = 0.f;
}

struct CvtM { const float* W; bf16x8* dst; const float* sa; const float* sb; int K, N, il4, base; };
DI void cvt_decode(const Params& p, int pc, CvtM& m) {
    constexpr int P_IN = (INW / 32) * 64 * 64, P_OUT = 32 * 64 * 64, P_S = 8 * 64 * 64, P_D = 32 * 16 * 64;
    m.sa = nullptr; m.sb = nullptr; m.il4 = 0; m.K = DM;
    if (pc < P_IN) { m.W = p.w_in; m.dst = (bf16x8*)(p.ws + WS_WIN); m.N = INW; m.base = 0; return; }
    if (pc < P_IN + P_OUT) { m.W = p.w_out; m.dst = (bf16x8*)(p.ws + WS_WOUT); m.N = DM; m.base = P_IN; m.sa = p.g_out_a; m.sb = p.g_out_b; m.il4 = 1; return; }
    if (pc < P_IN + P_OUT + P_S) { m.W = p.w_router; m.dst = (bf16x8*)(p.ws + WS_WR); m.N = NE; m.base = P_IN + P_OUT; return; }
    if (pc < P_IN + P_OUT + 2 * P_S) { m.W = p.w_gate_s; m.dst = (bf16x8*)(p.ws + WS_WGS); m.N = 256; m.base = P_IN + P_OUT + P_S; return; }
    if (pc < P_IN + P_OUT + 3 * P_S) { m.W = p.w_up_s; m.dst = (bf16x8*)(p.ws + WS_WUS); m.N = 256; m.base = P_IN + P_OUT + 2 * P_S; return; }
    m.W = p.w_down_s; m.dst = (bf16x8*)(p.ws + WS_WDS); m.N = DM; m.K = 256; m.base = P_IN + P_OUT + 3 * P_S; m.il4 = 1;
}
constexpr int CVT_TOTAL = (INW / 32) * 64 * 64 + 32 * 64 * 64 + 3 * 8 * 64 * 64 + 32 * 16 * 64;
DI void phase0(const Params& p, LAS char* lds, int vcu, int G, int wid) {
    const int lane = lane_opaque(), wv = wid_opaque(wid), tid = wv * 64 + lane;
    const int gtid = vcu * NTHR + tid, gth = G * NTHR;
    float wa[3][16]; int a_cc[3], a_ks[3];
#pragma unroll
    for (int m = 0; m < 3; ++m) {
        const int it = vcu + G * m; a_cc[m] = it % 96; a_ks[m] = (it / 96) & 7;
        const float* wp = p.w_ada + (size_t)(128 * a_ks[m] + 16 * wv) * 6144 + 64 * a_cc[m] + lane;
#pragma unroll
        for (int i = 0; i < 16; ++i) wa[m][i] = (it < 768) ? wp[(size_t)i * 6144] : 0.f;
    }
    float lv[5][8];
#pragma unroll
    for (int i = 0; i < 5; ++i) {
        const int pc0 = gtid + i * gth, pc = pc0 < CVT_TOTAL ? pc0 : 0;
        CvtM cm; cvt_decode(p, pc, cm);
        const int q = pc - cm.base, KS = cm.K / 16, l = q & 63, ks = (q >> 6) % KS, nt = (q >> 6) / KS;
        const int n = cm.il4 ? 128 * (nt >> 2) + 4 * (l & 31) + (nt & 3) : 32 * nt + (l & 31), k0 = 16 * ks + 8 * (l >> 5);
#pragma unroll
        for (int j = 0; j < 8; ++j) lv[i][j] = cm.W[(size_t)(k0 + j) * cm.N + n];
    }
    {
        float* cosT = (float*)(p.ws + WS_ROPE); float* sinT = cosT + (size_t)NTOK * 8;
        for (int e = gtid; e < NTOK * 8; e += gth) {
            const int t = e >> 3, i = e & 7;
            const float inv = (float)exp2(-(double)i * 0.125 * 18.931568569324174);
            const float ang = (float)p.pos[t] * inv;
            double rev = (double)ang * 0.15915494309189535; rev -= floor(rev);
            cosT[e] = __builtin_amdgcn_cosf((float)rev);
            sinT[e] = __builtin_amdgcn_sinf((float)rev);
        }
    }
    LAS float* red = (LAS float*)lds;
    LAS float* cond = (LAS float*)(lds + 16384);
#pragma unroll
    for (int m = 0; m < 3; ++m) {
        const int it = vcu + G * m;
        if (it < 768) {
            { const int kl = tid >> 2, b2 = (tid & 3) * 2;
              cond[kl * 8 + b2] = silu_f(p.c[b2 * DM + 128 * a_ks[m] + kl]); cond[kl * 8 + b2 + 1] = silu_f(p.c[(b2 + 1) * DM + 128 * a_ks[m] + kl]); }
            __syncthreads();
            float acc[8];
#pragma unroll
            for (int b = 0; b < 8; ++b) acc[b] = 0.f;
#pragma unroll
            for (int i = 0; i < 16; ++i) {
                const f32x4 c0 = *(const LAS f32x4*)(cond + (16 * wv + i) * 8), c1 = *(const LAS f32x4*)(cond + (16 * wv + i) * 8 + 4);
#pragma unroll
                for (int b = 0; b < 4; ++b) { acc[b] += c0[b] * wa[m][i]; acc[4 + b] += c1[b] * wa[m][i]; }
            }
#pragma unroll
            for (int b = 0; b < 8; ++b) red[(wv * 8 + b) * 64 + lane] = acc[b];
            __syncthreads();
            {
                const int b = tid >> 6, col = tid & 63;
                float s2 = 0.f;
#pragma unroll
                for (int w8 = 0; w8 < 8; ++w8) s2 += red[(w8 * 8 + b) * 64 + col];
                ((float*)(p.ws + WS_MODP))[(size_t)(a_ks[m] * 8 + b) * 6144 + 64 * a_cc[m] + col] = s2;
            }
            __syncthreads();
        }
    }
#pragma unroll
    for (int i = 0; i < 5; ++i) {
        const int pc = vcu * NTHR + wv * 64 + lane_opaque() + i * gth;
        if (pc < CVT_TOTAL) {
            CvtM cm; cvt_decode(p, pc, cm);
            const int q = pc - cm.base, KS = cm.K / 16, l = q & 63, ks = (q >> 6) % KS, k0 = 16 * ks + 8 * (l >> 5);
            bf16x8 v;
#pragma unroll
            for (int j = 0; j < 8; ++j) {
                float w = lv[i][j];
                if (cm.sa) { const int k = k0 + j; w *= (k < 512) ? cm.sa[k] : cm.sb[k - 512]; }
                v[j] = (bf16)w;
            }
            cm.dst[q] = v;
        }
    }
}

DI void phase1(const Params& p, LAS char* lds, int wg, int wid) {
    const int lane = lane_opaque(), wv = wid_opaque(wid), tid = wv * 64 + lane;
    const int t0 = wg * 64, b = t0 / SEQ;
    if (tid < 192) { const int idx = (wg & 31) * 192 + tid; ((float*)(p.ws + WS_MODF))[b * 6144 + idx] = mod_val(p, b, idx); }
    {
        float ga[16], sh[16];
#pragma unroll
        for (int j = 0; j < 4; ++j)
#pragma unroll
            for (int e = 0; e < 4; ++e) {
                const int k = 256 * j + 4 * lane + e;
                ga[4 * j + e] = p.g_mix[k] * (1.f + mod_val(p, b, 1 * DM + k));
                sh[4 * j + e] = mod_val(p, b, 0 * DM + k);
            }
#pragma unroll 1
        for (int i = 0; i < 8; ++i) {
            const int row = 8 * wv + i;
            const float* xr = p.x + (size_t)(t0 + row) * DM;
            f32x4 v[4]; float ss = 0.f;
#pragma unroll
            for (int j = 0; j < 4; ++j) { v[j] = *(const f32x4*)(xr + 256 * j + 4 * lane); ss += v[j][0] * v[j][0] + v[j][1] * v[j][1] + v[j][2] * v[j][2] + v[j][3] * v[j][3]; }
            const float rstd = rsqrtf(wave_sum(ss, lane) * (1.f / DM) + EPS);
#pragma unroll
            for (int j = 0; j < 4; ++j) {
                const bf16x4 o = pack4(v[j][0] * rstd * ga[4 * j] + sh[4 * j], v[j][1] * rstd * ga[4 * j + 1] + sh[4 * j + 1],
                                       v[j][2] * rstd * ga[4 * j + 2] + sh[4 * j + 2], v[j][3] * rstd * ga[4 * j + 3] + sh[4 * j + 3]);
                *(LAS bf16x4*)(lds + row * PITCH + (256 * j + 4 * lane) * 2) = o;
            }
        }
    }
    __syncthreads();
    const bf16x8* wsw = (const bf16x8*)(p.ws + WS_WIN);
    const float* cosT = (const float*)(p.ws + WS_ROPE); const float* sinT = cosT + (size_t)NTOK * 8;
    bf16* qkv = (bf16*)(p.ws + WS_QKV);
    const int h = lane >> 5;
#pragma unroll 1
    for (int u = wv; u < 36; u += NWAVE) {
        f32x16 acc[2][2]; zero_acc<2>(acc);
        const bf16x8* wp[2] = { wsw + (size_t)(2 * u) * 64 * 64 + lane, wsw + (size_t)(2 * u + 1) * 64 * 64 + lane };
        gemm_ct<2, 64>(acc, wp, lds, PITCH, lane);
        const float* g = nullptr; float qs = 1.f;
        if (u < 8) { g = p.g_q_a; qs = 0.125f; } else if (u < 10) g = p.g_k_a; else if (u >= 12 && u < 20) { g = p.g_q_b; qs = 0.125f; } else if (u >= 20 && u < 28) g = p.g_k_b;
#pragma unroll
        for (int tt = 0; tt < 2; ++tt) {
            const int tok = t0 + 32 * tt + (lane & 31);
            if (g) {
                float ss = 0.f;
#pragma unroll
                for (int nt = 0; nt < 2; ++nt)
#pragma unroll
                    for (int r = 0; r < 16; ++r) ss += acc[nt][tt][r] * acc[nt][tt][r];
                ss += shx(ss, 32, lane);
                const float rstd = rsqrtf(ss * (1.f / 64.f) + EPS);
#pragma unroll
                for (int nt = 0; nt < 2; ++nt)
#pragma unroll
                    for (int r = 0; r < 16; ++r) acc[nt][tt][r] *= rstd * g[32 * nt + crow(r, h)];
#pragma unroll
                for (int r = 0; r < 4; ++r) {
                    const int i = r + 4 * h;
                    const float cs = cosT[(size_t)tok * 8 + i], sn = sinT[(size_t)tok * 8 + i];
                    const float a1 = acc[0][tt][r], a2 = acc[0][tt][r + 4];
                    acc[0][tt][r] = a1 * cs - a2 * sn; acc[0][tt][r + 4] = a2 * cs + a1 * sn;
                }
            }
#pragma unroll
            for (int nt = 0; nt < 2; ++nt)
#pragma unroll
                for (int g4 = 0; g4 < 4; ++g4) {
                    const bf16x4 o = pack4(acc[nt][tt][4 * g4] * qs, acc[nt][tt][4 * g4 + 1] * qs, acc[nt][tt][4 * g4 + 2] * qs, acc[nt][tt][4 * g4 + 3] * qs);
                    *(bf16x4*)(qkv + (size_t)tok * INW + 64 * u + 32 * nt + 8 * g4 + 4 * h) = o;
                }
        }
    }
}

constexpr int VP = 192;
DI void attn_unit(const Params& p, LAS char* vimg, int u, int lane) {
    const int combo = u & 31, blk = (u >> 5) & 31, b = u >> 10;
    const int h = lane >> 5, l31 = lane & 31;
    int qoff, koff, voff, dil, maxd; float m_init, l_init; bf16* outp; float* lsep = nullptr; int hb;
    if (combo < 8) {
        hb = combo; qoff = 64 * hb; koff = KA_OFF + 64 * (hb >> 2); voff = VA_OFF + 64 * (hb >> 2); dil = 1; maxd = 127;
        m_init = p.sinks[hb]; l_init = 1.f; outp = (bf16*)(p.ws + WS_OA);
    } else {
        const int br = (combo - 8) >> 3; hb = (combo - 8) & 7;
        qoff = QB_OFF + 64 * hb; koff = KB_OFF + 64 * hb; voff = VB_OFF + 64 * hb; dil = (br == 0) ? 1 : (br == 1 ? 4 : 16); maxd = 128;
        m_init = -1e30f; l_init = 0.f; outp = (bf16*)(p.ws + WS_OB) + (size_t)br * NTOK * 512; lsep = (float*)(p.ws + WS_LSE) + (size_t)br * NTOK * 8;
    }
    const int L = SEQ / dil, nb = L / 64, rho = blk / nb, l0 = (blk % nb) * 64;
    const bf16* qkv = (const bf16*)(p.ws + WS_QKV) + (size_t)b * SEQ * INW;
    bf16x8 qf[2][4];
#pragma unroll
    for (int qt = 0; qt < 2; ++qt) {
        const bf16* qp = qkv + (size_t)((l0 + 32 * qt + l31) * dil + rho) * INW + qoff + 8 * h;
#pragma unroll
        for (int s = 0; s < 4; ++s) qf[qt][s] = *(const bf16x8*)(qp + 16 * s);
    }
    f32x16 o[2][2];
#pragma unroll
    for (int dt = 0; dt < 2; ++dt)
#pragma unroll
        for (int qt = 0; qt < 2; ++qt)
#pragma unroll
            for (int r = 0; r < 16; ++r) o[dt][qt][r] = 0.f;
    float mrun[2] = { m_init, m_init }, lrun[2] = { h == 0 ? l_init : 0.f, h == 0 ? l_init : 0.f };
    const float LOG2E = 1.4426950408889634f;
#pragma unroll 1
    for (int kt = 0; kt < 6; ++kt) {
        const int lk0 = l0 - 128 + 32 * kt;
        if (lk0 + 31 < 0) continue;
        bf16x8 kf[4];
        {
            int lk = lk0 + l31; lk = lk < 0 ? 0 : lk;
            const bf16* kp = qkv + (size_t)(lk * dil + rho) * INW + koff + 8 * h;
#pragma unroll
            for (int s = 0; s < 4; ++s) kf[s] = *(const bf16x8*)(kp + 16 * s);
        }
        {
            bf16x8 vr[4];
#pragma unroll
            for (int i = 0; i < 4; ++i) {
                int lk = lk0 + (lane >> 3) + 8 * i; lk = lk < 0 ? 0 : lk;
                vr[i] = *(const bf16x8*)(qkv + (size_t)(lk * dil + rho) * INW + voff + 8 * (lane & 7));
            }
#pragma unroll
            for (int i = 0; i < 4; ++i) *(LAS bf16x8*)(vimg + ((lane >> 3) + 8 * i) * VP + 16 * (lane & 7)) = vr[i];
        }
        bf16x8 vf[2][2];
        {
            const int g1 = (lane >> 4) & 1, q4 = (lane & 15) >> 2, p4 = lane & 3;
#pragma unroll
            for (int dt = 0; dt < 2; ++dt)
#pragma unroll
                for (int s = 0; s < 2; ++s) {
                    const LAS char* a0 = vimg + (16 * s + 4 * h + q4) * VP + (32 * dt + 16 * g1 + 4 * p4) * 2;
                    const s16x4 lo = __builtin_amdgcn_ds_read_tr16_b64_v4i16((LAS s16x4*)a0);
                    const s16x4 hi = __builtin_amdgcn_ds_read_tr16_b64_v4i16((LAS s16x4*)(a0 + 8 * VP));
                    const s16x8 c = __builtin_shufflevector(lo, hi, 0, 1, 2, 3, 4, 5, 6, 7);
                    vf[dt][s] = __builtin_bit_cast(bf16x8, c);
                }
        }
#pragma unroll
        for (int qt = 0; qt < 2; ++qt) {
            if ((qt == 0 && kt == 5) || (qt == 1 && kt == 0)) continue;
            f32x16 sacc;
#pragma unroll
            for (int r = 0; r < 16; ++r) sacc[r] = 0.f;
#pragma unroll
            for (int s = 0; s < 4; ++s) sacc = MFMA32(kf[s], qf[qt][s], sacc);
            const int lq = l0 + 32 * qt + l31;
            float mx = -1e30f;
#pragma unroll
            for (int r = 0; r < 16; ++r) {
                const int lk = lk0 + crow(r, h), d = lq - lk;
                const bool ok = (lk >= 0) && (d >= 0) && (d <= maxd);
                sacc[r] = ok ? sacc[r] : -1e30f;
                mx = fmaxf(mx, sacc[r]);
            }
            mx = fmaxf(mx, shx(mx, 32, lane));
            const float mnew = fmaxf(mrun[qt], mx);
            const float alpha = exp2f((mrun[qt] - mnew) * LOG2E);
            float ps = 0.f;
#pragma unroll
            for (int r = 0; r < 16; ++r) { sacc[r] = exp2f((sacc[r] - mnew) * LOG2E); ps += sacc[r]; }
            lrun[qt] = lrun[qt] * alpha + ps; mrun[qt] = mnew;
#pragma unroll
            for (int dt = 0; dt < 2; ++dt)
#pragma unroll
                for (int r = 0; r < 16; ++r) o[dt][qt][r] *= alpha;
            bf16x8 pf[2];
#pragma unroll
            for (int s = 0; s < 2; ++s)
#pragma unroll
                for (int j = 0; j < 8; ++j) pf[s][j] = (bf16)sacc[8 * s + j];
#pragma unroll
            for (int dt = 0; dt < 2; ++dt)
#pragma unroll
                for (int s = 0; s < 2; ++s) o[dt][qt] = MFMA32(vf[dt][s], pf[s], o[dt][qt]);
        }
    }
#pragma unroll
    for (int qt = 0; qt < 2; ++qt) {
        const float lt = lrun[qt] + shx(lrun[qt], 32, lane);
        const float inv = 1.f / lt;
        const size_t tok = (size_t)b * SEQ + (size_t)(l0 + 32 * qt + l31) * dil + rho;
#pragma unroll
        for (int dt = 0; dt < 2; ++dt)
#pragma unroll
            for (int g4 = 0; g4 < 4; ++g4) {
                const bf16x4 v = pack4(o[dt][qt][4 * g4] * inv, o[dt][qt][4 * g4 + 1] * inv, o[dt][qt][4 * g4 + 2] * inv, o[dt][qt][4 * g4 + 3] * inv);
                *(bf16x4*)(outp + tok * 512 + 64 * hb + 32 * dt + 8 * g4 + 4 * h) = v;
            }
        if (lsep && h == 0) lsep[tok * 8 + hb] = mrun[qt] + logf(lt);
    }
}
DI void phase2(const Params& p, LAS char* lds, int vcu, int G, int wid) {
    const int lane = lane_opaque(), wv = wid_opaque(wid), tid = wv * 64 + lane;
    LAS char* vimg = lds + wv * (32 * VP);
    for (int u = vcu * NWAVE + wv; u < 8192; u += G * NWAVE) attn_unit(p, vimg, u, lane);
}

DI void phase3(const Params& p, LAS char* lds, int wg, int wid) {
    const int lane = lane_opaque(), wv = wid_opaque(wid), tid = wv * 64 + lane, h = lane >> 5, l31 = lane & 31;
    const int t0 = wg * 64, b = t0 / SEQ;
    LAS float* ga_l = (LAS float*)(lds + LDS_MISC + 2048);
    LAS float* hs_l = ga_l + 1024;
    LAS float* sh_l = hs_l + 1024;
    LAS float* gm_l = sh_l + 1024;
    LAS unsigned* lcnt = (LAS unsigned*)(lds + LDS_MISC + 18432 + 256);
    LAS unsigned* lbase = lcnt + 256;
    if (tid < NE) lcnt[tid] = 0u;
    {
        const float* mf = (const float*)(p.ws + WS_MODF) + b * 6144;
        for (int n = tid; n < DM; n += NTHR) { ga_l[n] = mf[2 * DM + n]; hs_l[n] = p.g_ffn[n] * (1.f + mf[4 * DM + n]); sh_l[n] = mf[3 * DM + n]; gm_l[n] = mf[5 * DM + n]; }
    }
    {
        const bf16* oa = (const bf16*)(p.ws + WS_OA); const bf16* ob = (const bf16*)(p.ws + WS_OB); const float* lse = (const float*)(p.ws + WS_LSE);
#pragma unroll 1
        for (int ib = 0; ib < 2; ++ib) {
            bf16x8 d[4][3][2]; float e3[4][3];
#pragma unroll
            for (int i = 0; i < 4; ++i) {
                const size_t tok = t0 + 8 * wv + 4 * ib + i;
                if (h == 0) {
                    d[i][0][0] = *(const bf16x8*)(oa + tok * 512 + 16 * l31); d[i][0][1] = *(const bf16x8*)(oa + tok * 512 + 16 * l31 + 8);
                } else {
                    const int hd = l31 >> 2;
#pragma unroll
                    for (int br = 0; br < 3; ++br) {
                        const bf16* src = ob + (size_t)br * NTOK * 512 + tok * 512 + 16 * l31;
                        d[i][br][0] = *(const bf16x8*)src; d[i][br][1] = *(const bf16x8*)(src + 8);
                        e3[i][br] = lse[(size_t)br * NTOK * 8 + tok * 8 + hd];
                    }
                }
            }
#pragma unroll
            for (int i = 0; i < 4; ++i) {
                const int row = 8 * wv + 4 * ib + i;
                float v[16];
                if (h == 0) {
#pragma unroll
                    for (int j = 0; j < 8; ++j) { v[j] = (float)d[i][0][0][j]; v[8 + j] = (float)d[i][0][1][j]; }
                } else {
                    const float mx = fmaxf(e3[i][0], fmaxf(e3[i][1], e3[i][2]));
                    float w0 = __expf(e3[i][0] - mx), w1 = __expf(e3[i][1] - mx), w2 = __expf(e3[i][2] - mx);
                    const float wi = 1.f / (w0 + w1 + w2); w0 *= wi; w1 *= wi; w2 *= wi;
#pragma unroll
                    for (int j = 0; j < 8; ++j) {
                        v[j] = w0 * (float)d[i][0][0][j] + w1 * (float)d[i][1][0][j] + w2 * (float)d[i][2][0][j];
                        v[8 + j] = w0 * (float)d[i][0][1][j] + w1 * (float)d[i][1][1][j] + w2 * (float)d[i][2][1][j];
                    }
                }
                float ss = 0.f;
#pragma unroll
                for (int j = 0; j < 16; ++j) ss += v[j] * v[j];
#pragma unroll
                for (int o2 = 1; o2 < 32; o2 <<= 1) ss += shx(ss, o2, lane);
                const float rstd = rsqrtf(ss * (1.f / 512.f) + EPS);
                bf16x8 o0, o1;
#pragma unroll
                for (int j = 0; j < 8; ++j) { o0[j] = (bf16)(v[j] * rstd); o1[j] = (bf16)(v[8 + j] * rstd); }
                LAS char* dst = lds + row * PITCH + (512 * h + 16 * l31) * 2;
                *(LAS bf16x8*)dst = o0; *(LAS bf16x8*)(dst + 16) = o1;
            }
        }
    }
    __syncthreads();
    f32x16 x1[4][2]; zero_acc<4>(x1);
    {
        const bf16x8* wsw = (const bf16x8*)(p.ws + WS_WOUT);
        const bf16x8* wp[4];
#pragma unroll
        for (int i = 0; i < 4; ++i) wp[i] = wsw + (size_t)(4 * wv + i) * 64 * 64 + lane;
        gemm_ct<4, 64, true>(x1, wp, lds, PITCH, lane);
    }
    LAS float* ssx = (LAS float*)(lds + LDS_MISC);
    LAS float* rsx = (LAS float*)(lds + LDS_MISC + 18432);
    {
        const int lane = lane_opaque(), h = lane >> 5, l31 = lane & 31, nb = 128 * wv + 4 * l31;
        const f32x4 ga4 = *(const LAS f32x4*)(ga_l + nb);
        float q[32];
#pragma unroll
        for (int tt = 0; tt < 2; ++tt)
#pragma unroll
            for (int r = 0; r < 16; ++r) {
                const size_t tok = t0 + 32 * tt + crow(r, h);
                const f32x4 xv = *(const f32x4*)(p.x + tok * DM + nb);
                f32x4 ov; float ss = 0.f;
#pragma unroll
                for (int e = 0; e < 4; ++e) { const float v = xv[e] + ga4[e] * x1[e][tt][r]; x1[e][tt][r] = v; ov[e] = v; ss += v * v; }
                *(f32x4*)(p.out + tok * DM + nb) = ov;
                q[16 * tt + r] = ss;
                if ((r & 7) == 7) __builtin_amdgcn_sched_barrier(0);
            }
        const float tot = butterfly32(q, lane);
        ssx[wv * 64 + 32 * (l31 >> 4) + crow(l31 & 15, h)] = tot;
    }
    __syncthreads();
    { const int tid2 = wv * 64 + lane_opaque();
      if (tid2 < 64) { float ss = 0.f;
#pragma unroll
        for (int w8 = 0; w8 < 8; ++w8) ss += ssx[w8 * 64 + tid2];
        rsx[tid2] = rsqrtf(ss * (1.f / DM) + EPS); } }
    __syncthreads();
    {
        const int lane = lane_opaque(), h = lane >> 5, l31 = lane & 31, nb = 128 * wv + 4 * l31;
        bf16* h2g = (bf16*)(p.ws + WS_H2);
        const f32x4 hs4 = *(const LAS f32x4*)(hs_l + nb), sh4 = *(const LAS f32x4*)(sh_l + nb);
#pragma unroll
        for (int tt = 0; tt < 2; ++tt)
#pragma unroll
            for (int r = 0; r < 16; ++r) {
                const int row = 32 * tt + crow(r, h); const size_t tok = t0 + row;
                const float rstd = rsx[row];
                const bf16x4 o = pack4(x1[0][tt][r] * rstd * hs4[0] + sh4[0], x1[1][tt][r] * rstd * hs4[1] + sh4[1], x1[2][tt][r] * rstd * hs4[2] + sh4[2], x1[3][tt][r] * rstd * hs4[3] + sh4[3]);
                *(LAS bf16x4*)(lds + row * PITCH + nb * 2) = o;
                *(bf16x4*)(h2g + tok * DM + nb) = o;
                if ((r & 3) == 3) __builtin_amdgcn_sched_barrier(0);
            }
    }
    __syncthreads();
    float* logit = (float*)(p.ws + WS_LOG);
    f32x16 gu[3][2]; zero_acc<3>(gu);
    {
        const bf16x8* wp[3] = { (const bf16x8*)(p.ws + WS_WR) + (size_t)wv * 64 * 64 + lane, (const bf16x8*)(p.ws + WS_WGS) + (size_t)wv * 64 * 64 + lane,
                                (const bf16x8*)(p.ws + WS_WUS) + (size_t)wv * 64 * 64 + lane };
        gemm_ct<3, 64, true>(gu, wp, lds, PITCH, lane);
        const int lane = lane_opaque(), h = lane >> 5, l31 = lane & 31;
#pragma unroll
        for (int tt = 0; tt < 2; ++tt)
#pragma unroll
            for (int r = 0; r < 16; ++r) logit[(size_t)(t0 + 32 * tt + crow(r, h)) * NE + 32 * wv + l31] = gu[0][tt][r];
    }
    asm volatile("s_waitcnt vmcnt(0)" ::: "memory");
    __syncthreads();
    constexpr int AP = 528;
    { const int lane = lane_opaque(), h = lane >> 5, l31 = lane & 31;
#pragma unroll
      for (int tt = 0; tt < 2; ++tt)
#pragma unroll
        for (int r = 0; r < 16; ++r)
            *(LAS bf16*)(lds + (32 * tt + crow(r, h)) * AP + (32 * wv + l31) * 2) = (bf16)(silu_f(gu[1][tt][r]) * gu[2][tt][r]); }
    int k_exp, k_asg; unsigned k_lpos; float k_gate;
    {
        const int lane = lane_opaque(); int t0y = t0; asm volatile("" : "+s"(t0y));
        const int g = lane & 7; const size_t tok = t0y + 8 * wv + (lane >> 3);
        unsigned key[32];
        const float* lp = logit + tok * NE + 32 * g;
        float m1 = -INFINITY, m2 = -INFINITY;
#pragma unroll
        for (int j = 0; j < 8; ++j) {
            const f32x4 v = __builtin_nontemporal_load((const f32x4*)(lp + 4 * j));
            const f32x4 rb = *(const f32x4*)(p.r_bias + 32 * g + 4 * j);
#pragma unroll
            for (int e = 0; e < 4; ++e) {
                const float bv = __builtin_amdgcn_rcpf(1.f + __expf(-v[e])) + rb[e];
                key[4 * j + e] = (__float_as_uint(bv + 1.0f) & 0xFFFFFF00u) | (unsigned)(255 - (32 * g + 4 * j + e));
                const float hi = fmaxf(m1, bv), lo = fminf(m1, bv); m1 = hi; m2 = fmaxf(m2, lo);
            }
        }
        const float gs = m1 + m2;
        int rank = 0;
#pragma unroll
        for (int o2 = 0; o2 < 8; ++o2) { const float og = shidx(gs, (lane & ~7) | o2, lane); rank += (og > gs || (og == gs && o2 < g)) ? 1 : 0; }
        if (rank >= 4) {
#pragma unroll
            for (int j = 0; j < 32; ++j) key[j] = 0u;
        }
        unsigned mykey = 0u;
#pragma unroll 1
        for (int k = 0; k < 8; ++k) {
            unsigned kw = 0u;
#pragma unroll
            for (int j = 0; j < 32; ++j) kw = max(kw, key[j]);
#pragma unroll
            for (int o2 = 1; o2 < 8; o2 <<= 1) kw = max(kw, (unsigned)shxi((int)kw, o2, lane));
#pragma unroll
            for (int j = 0; j < 32; ++j) key[j] = (key[j] == kw) ? 0u : key[j];
            if (k == g) mykey = kw;
        }
        const int myexp = 255 - (int)(mykey & 0xFFu);
        const float myscore = __builtin_amdgcn_rcpf(1.f + __expf(-__builtin_nontemporal_load(logit + tok * NE + myexp)));
        float ssum = myscore;
#pragma unroll
        for (int o2 = 1; o2 < 8; o2 <<= 1) ssum += shx(ssum, o2, lane);
        const float gate = myscore / ssum * 2.5f;
        k_exp = myexp; k_gate = gate; k_asg = (int)tok * 8 + g;
        k_lpos = __hip_atomic_fetch_add(&lcnt[myexp], 1u, __ATOMIC_RELAXED, __HIP_MEMORY_SCOPE_WORKGROUP);
    }
    __syncthreads();
    unsigned k_gb = 0u;
    { const int tid2 = wv * 64 + lane_opaque();
      if (tid2 < NE) { const unsigned c = lcnt[tid2]; if (c) k_gb = atomicAdd((unsigned*)(p.ws + WS_CTL + CTL_CNT) + tid2, c); } }
    {
        f32x16 yd[4][2]; zero_acc<4>(yd);
        const bf16x8* wsw = (const bf16x8*)(p.ws + WS_WDS);
        const bf16x8* wp[4];
#pragma unroll
        for (int i = 0; i < 4; ++i) wp[i] = wsw + (size_t)(4 * wv + i) * 16 * 64 + lane;
        gemm_ct<4, 16, true>(yd, wp, lds, AP, lane);
        int t0x = t0; asm volatile("" : "+s"(t0x));
        const int lane2 = lane_opaque(), nb2 = 128 * wv + 4 * (lane2 & 31), h2 = lane2 >> 5;
        const f32x4 gm4 = *(const LAS f32x4*)(gm_l + nb2);
#pragma unroll
        for (int tt = 0; tt < 2; ++tt)
#pragma unroll
            for (int r = 0; r < 16; ++r) {
                float* op = p.out + (size_t)(t0x + 32 * tt + crow(r, h2)) * DM + nb2;
                f32x4 ov = *(f32x4*)op;
#pragma unroll
                for (int e = 0; e < 4; ++e) ov[e] += gm4[e] * yd[e][tt][r];
                *(f32x4*)op = ov;
                if ((r & 7) == 7) __builtin_amdgcn_sched_barrier(0);
            }
    }
    {
        const int tid2 = wv * 64 + lane_opaque();
        if (tid2 < NE) lbase[tid2] = k_gb;
        __syncthreads();
        const unsigned pos = lbase[k_exp] + k_lpos;
        ((int*)(p.ws + WS_LIST))[(size_t)k_exp * LCAP + pos] = k_asg;
        ((float*)(p.ws + WS_GATE))[k_asg] = k_gate;
    }
}

constexpr int EAP = 144;
constexpr int ACTP = 528;
constexpr int L4_ABUF = 0;
constexpr int L4_ACT = 0;
constexpr int L4_ROW = 135168;
constexpr int L4_GATE = L4_ROW + 1024;
constexpr int L4_YOFF = L4_GATE + 1024;
constexpr int L4_NCH = L4_YOFF + 1024;
constexpr int L4_PFX = L4_NCH + 1024;
constexpr int L4_ITEM = L4_PFX + 1040;
constexpr int L4_WSC = 141312;
constexpr int WSC_BYTES = 2560;
static_assert(L4_ITEM + 16 <= L4_WSC && L4_WSC + 8 * WSC_BYTES + 8 * 33 * 4 <= LDS_BARW, "P4 LDS layout");
struct WRaw { f32x4 v[2]; };
DI void load_wraw(WRaw& d, const float* base, int ld, int loff) {
    d.v[0] = *(const f32x4*)(base + loff);
    d.v[1] = *(const f32x4*)(base + (size_t)8 * ld + loff);
}
DI bf16x8 wfrag_from(const WRaw& d, LAS char* wsc, int lane) {
    const int wo = (lane >> 3) * 64 + (lane & 7) * 8;
    *(LAS bf16x4*)(wsc + wo) = pack4(d.v[0][0], d.v[0][1], d.v[0][2], d.v[0][3]);
    *(LAS bf16x4*)(wsc + wo + 512) = pack4(d.v[1][0], d.v[1][1], d.v[1][2], d.v[1][3]);
    const LAS char* ra = wsc + (8 * (lane >> 5) + ((lane & 15) >> 2)) * 64 + (16 * ((lane >> 4) & 1) + 4 * (lane & 3)) * 2;
    const s16x4 lo = __builtin_amdgcn_ds_read_tr16_b64_v4i16((LAS s16x4*)ra);
    const s16x4 hi = __builtin_amdgcn_ds_read_tr16_b64_v4i16((LAS s16x4*)(ra + 4 * 64));
    const s16x8 c = __builtin_shufflevector(lo, hi, 0, 1, 2, 3, 4, 5, 6, 7);
    return __builtin_bit_cast(bf16x8, c);
}
#ifndef PFW2
#define PFW2 4
#endif
#ifndef PFW
#define PFW 4
#endif
struct P4St { WRaw raw[4]; bf16x8 sa[4], sb[4]; };
DI void p4_issue(P4St& S, const float* wb, int loff, const bf16* h2g, const int (&roff)[4]) {
#pragma unroll
    for (int i = 0; i < 4; ++i) S.sa[i] = *(const bf16x8*)(h2g + roff[i]);
#pragma unroll
    for (int q = 0; q < 4; ++q) load_wraw(S.raw[q], wb + (size_t)q * 16 * ED, ED, loff);
#pragma unroll
    for (int i = 0; i < 4; ++i) S.sb[i] = *(const bf16x8*)(h2g + roff[i] + 64);
}
template <int NRT>
DI void p4_chunk(f32x16 (&acc)[NRT], P4St& S, bf16x8& wf, bf16x8 (&snew)[4], const bf16x8 (&swr_regs)[4], int kc, const float* wb, int loff, const bf16* h2g, const int (&roff)[4],
                 LAS char* lds, LAS char* wsc, int swr, int lane, int l31, int h) {
    {
        const int kn = (kc + 2) & 15;
#pragma unroll
        for (int i = 0; i < 4; ++i) snew[i] = *(const bf16x8*)(h2g + roff[i] + 64 * kn);
    }
    const int bcur = kc % 3, bnxt = (kc + 1) % 3;
    const LAS char* ab = lds + L4_ABUF + bcur * (256 * EAP) + l31 * EAP + 16 * h;
#pragma unroll
    for (int s = 0; s < 4; ++s) {
        const int ks = 4 * kc + s;
        const bf16x8 wfn = wfrag_from(S.raw[(s + 1) & 3], wsc, lane);
        load_wraw(S.raw[(s + 1) & 3], wb + (size_t)((ks + 5) & 63) * 16 * ED, ED, loff);
#pragma unroll
        for (int g = 0; g < NRT; g += 4) {
            bf16x8 bt[4];
#pragma unroll
            for (int rt = 0; rt < 4; ++rt) if (g + rt < NRT) bt[rt] = *(const LAS bf16x8*)(ab + (g + rt) * 32 * EAP + 32 * s);
#pragma unroll
            for (int rt = 0; rt < 4; ++rt) if (g + rt < NRT) acc[g + rt] = MFMA32(wf, bt[rt], acc[g + rt]);
        }
        __builtin_amdgcn_sched_barrier(0);
        wf = wfn;
    }
#pragma unroll
    for (int i = 0; i < 4; ++i) *(LAS bf16x8*)(lds + L4_ABUF + bnxt * (256 * EAP) + swr + i * 8 * EAP) = swr_regs[i];
    __syncthreads();
}
template <int NRT>
DI void p4_run(f32x16 (&acc)[NRT], P4St& S, const float* wb, int loff, const bf16* h2g, const int (&roff)[4], LAS char* lds, int wv, int lane, int l31, int h) {
#pragma unroll
    for (int rt = 0; rt < NRT; ++rt)
#pragma unroll
        for (int r = 0; r < 16; ++r) acc[rt][r] = 0.f;
    const int swr = (32 * wv + (lane >> 3)) * EAP + 16 * (lane & 7);
    LAS char* wsc = lds + L4_WSC + wv * WSC_BYTES;
#pragma unroll
    for (int i = 0; i < 4; ++i) *(LAS bf16x8*)(lds + L4_ABUF + swr + i * 8 * EAP) = S.sa[i];
    bf16x8 wf = wfrag_from(S.raw[0], wsc, lane);
    load_wraw(S.raw[0], wb + (size_t)4 * 16 * ED, ED, loff);
    __syncthreads();
#pragma unroll 1
    for (int kc = 0; kc < 16; kc += 2) {
        p4_chunk<NRT>(acc, S, wf, S.sa, S.sb, kc, wb, loff, h2g, roff, lds, wsc, swr, lane, l31, h);
        p4_chunk<NRT>(acc, S, wf, S.sb, S.sa, kc + 1, wb, loff, h2g, roff, lds, wsc, swr, lane, l31, h);
    }
}
template <int NRT>
DI void p4_item(const Params& p, LAS char* lds, int e, int nrows, int wv, int vcu) {
    LAS int* rowasg = (LAS int*)(lds + L4_ROW);
    LAS float* rowgate = (LAS float*)(lds + L4_GATE);
    const int lane = lane_opaque(), h = lane >> 5, l31 = lane & 31;
    bf16x8* dump = (bf16x8*)(p.ws + WS_SG) + (size_t)(vcu * NWAVE + wv) * 16 * 64 + lane;
    const bf16* h2g = (const bf16*)(p.ws + WS_H2);
    int roff[4];
#pragma unroll
    for (int i = 0; i < 4; ++i) roff[i] = (rowasg[32 * wv + 8 * i + (lane >> 3)] >> 3) * DM + 8 * (lane & 7);
    bf16* ybuf = (bf16*)(p.ws + WS_Y);
    f32x16 acc[NRT];
    const int loff1 = (lane >> 3) * ED + 4 * (lane & 7);
    const float* wgb = p.w_gate_e + (size_t)e * DM * ED + 32 * wv;
    const float* wub = p.w_up_e + (size_t)e * DM * ED + 32 * wv;
    P4St S;
    p4_issue(S, wgb, loff1, h2g, roff);
    p4_run<NRT>(acc, S, wgb, loff1, h2g, roff, lds, wv, lane, l31, h);
    p4_issue(S, wub, loff1, h2g, roff);
#pragma unroll
    for (int rt = 0; rt < NRT; ++rt) {
        bf16x8 d0, d1;
#pragma unroll
        for (int j = 0; j < 8; ++j) { d0[j] = (bf16)silu_f(acc[rt][j]); d1[j] = (bf16)silu_f(acc[rt][8 + j]); }
        dump[(2 * rt) * 64] = d0; dump[(2 * rt + 1) * 64] = d1;
        __builtin_amdgcn_sched_barrier(0);
    }
    p4_run<NRT>(acc, S, wub, loff1, h2g, roff, lds, wv, lane, l31, h);
    const int loff2 = (lane_opaque() >> 3) * DM + 4 * (lane_opaque() & 7);
    const float* wdb = p.w_down_e + (size_t)e * ED * DM + 32 * wv;
    WRaw raw[4];
#pragma unroll
    for (int q = 0; q < 4; ++q) load_wraw(raw[q], wdb + (size_t)q * 16 * DM, DM, loff2);
    const bf16x8* dump2 = (const bf16x8*)(p.ws + WS_SG) + (size_t)(vcu * NWAVE + wv) * 16 * 64 + lane_opaque();
#pragma unroll
    for (int rt = 0; rt < NRT; ++rt) {
        const bf16x8 d0 = __builtin_nontemporal_load(&dump2[(2 * rt) * 64]), d1 = __builtin_nontemporal_load(&dump2[(2 * rt + 1) * 64]);
        const float gq = rowgate[32 * rt + l31];
        LAS char* dst = lds + L4_ACT + (32 * rt + l31) * ACTP + (32 * wv + 4 * h) * 2;
#pragma unroll
        for (int g4 = 0; g4 < 4; ++g4) {
            float a[4];
#pragma unroll
            for (int e2 = 0; e2 < 4; ++e2) { const int r = 4 * g4 + e2; a[e2] = (float)(r < 8 ? d0[r] : d1[r - 8]) * acc[rt][r] * gq; }
            *(LAS bf16x4*)(dst + 16 * g4) = pack4(a[0], a[1], a[2], a[3]);
        }
    }
    __syncthreads();
    {
        LAS char* wsc = lds + L4_WSC + wv * WSC_BYTES;
        const LAS char* ab = lds + L4_ACT + l31 * ACTP + 16 * h;
        bf16x8 wf = wfrag_from(raw[0], wsc, lane);
        load_wraw(raw[0], wdb + (size_t)4 * 16 * DM, DM, loff2);
        bf16x8 bt[NRT];
#pragma unroll
        for (int rt = 0; rt < NRT; ++rt) bt[rt] = *(const LAS bf16x8*)(ab + rt * 32 * ACTP);
#pragma unroll 1
        for (int np = 0; np < 4; ++np) {
#pragma unroll
            for (int rt = 0; rt < NRT; ++rt)
#pragma unroll
                for (int r = 0; r < 16; ++r) acc[rt][r] = 0.f;
#pragma unroll 1
            for (int k4 = 0; k4 < 16; k4 += 4) {
#pragma unroll
                for (int q = 0; q < 4; ++q) {
                    const int ks = k4 + q, gn = (16 * np + ks + 5) & 63;
                    const bf16x8 wfn = wfrag_from(raw[(q + 1) & 3], wsc, lane);
                    load_wraw(raw[(q + 1) & 3], wdb + (size_t)(gn & 15) * 16 * DM + 256 * (gn >> 4), DM, loff2);
                    bf16x8 btn[NRT];
#pragma unroll
                    for (int rt = 0; rt < NRT; ++rt) btn[rt] = *(const LAS bf16x8*)(ab + rt * 32 * ACTP + 32 * ((ks + 1) & 15));
                    __builtin_amdgcn_sched_barrier(0);
#pragma unroll
                    for (int rt = 0; rt < NRT; ++rt) acc[rt] = MFMA32(wf, bt[rt], acc[rt]);
                    __builtin_amdgcn_sched_barrier(0);
                    wf = wfn;
#pragma unroll
                    for (int rt = 0; rt < NRT; ++rt) bt[rt] = btn[rt];
                }
            }
            const int n0 = 256 * np + 32 * wv;
            {
                int lo2 = lane; asm volatile("" : "+v"(lo2));
                const int trow = lo2 >> 2, tpc = lo2 & 3;
                LAS char* wt = wsc + (lo2 & 31) * 80 + 8 * (lo2 >> 5);
                const LAS char* rd = wsc + trow * 80 + tpc * 16;
                const LAS char* yo = lds + L4_YOFF + 4 * trow;
                const unsigned colb = (unsigned)(n0 + 8 * tpc) * 2u;
#pragma unroll
                for (int rt = 0; rt < NRT; ++rt) {
#pragma unroll
                    for (int g4 = 0; g4 < 4; ++g4)
                        *(LAS bf16x4*)(wt + 16 * g4) = pack4(acc[rt][4 * g4], acc[rt][4 * g4 + 1], acc[rt][4 * g4 + 2], acc[rt][4 * g4 + 3]);
#pragma unroll
                    for (int j2 = 0; j2 < 2; ++j2) {
                        const bf16x8 v = *(const LAS bf16x8*)(rd + j2 * 16 * 80);
                        const unsigned off = (unsigned)*(const LAS int*)(yo + 4 * (32 * rt + 16 * j2)) + colb;
                        *(bf16x8*)((char*)ybuf + off) = v;
                    }
                    __builtin_amdgcn_sched_barrier(0);
                }
            }
        }
    }
    __syncthreads();
}
constexpr int L4_PFX8 = L4_PFX;
static_assert(8 * 33 * 4 <= 1040 + 0 || true, "");
DI void phase4(const Params& p, LAS char* lds, int vcu, int G, int wid, unsigned* qctr) {
    const int wv = wid_opaque(wid);
    const unsigned* cnt = (const unsigned*)(p.ws + WS_CTL + CTL_CNT);
    LAS int* nchs = (LAS int*)(lds + L4_NCH);
    LAS int* pfx8 = (LAS int*)(lds + L4_WSC);
    pfx8 = (LAS int*)(lds + L4_WSC + 8 * WSC_BYTES);
    LAS int* rowasg = (LAS int*)(lds + L4_ROW);
    LAS float* rowgate = (LAS float*)(lds + L4_GATE);
    volatile LAS int* itemw = (volatile LAS int*)(lds + L4_ITEM);
    LAS int* ord8 = (LAS int*)(lds + L4_PFX);
    {
        const int tid = wv * 64 + lane_opaque();
        LAS int* rpcs = (LAS int*)(lds + L4_WSC);
        if (tid < NE) { const int ne = (int)cnt[tid], nch = (ne + 255) >> 8; nchs[tid] = nch; rpcs[tid] = nch ? ((((ne + nch - 1) / nch) + 31) & ~31) : 0; }
        __syncthreads();
        if (tid < NE) {
            const int x = tid & 7, j = tid >> 3, mine = rpcs[tid];
            int rank = 0;
            for (int j2 = 0; j2 < 32; ++j2) { const int o = rpcs[8 * j2 + x]; rank += (o > mine || (o == mine && j2 < j)) ? 1 : 0; }
            ord8[x * 32 + rank] = j;
        }
        __syncthreads();
        if (tid < 8 * 33) { const int x = tid / 33, r = tid % 33; int s = 0; for (int i = 0; i < r; ++i) s += nchs[8 * ord8[x * 32 + i] + x]; pfx8[tid] = s; }
        __syncthreads();
    }
    const int* list = (const int*)(p.ws + WS_LIST);
    const float* gatebuf = (const float*)(p.ws + WS_GATE);
    const int myx = (int)(xb_xcc_id() & 7u);
#pragma unroll 1
    for (int sx = 0; sx < 8; ++sx) {
        const int x = (myx + sx) & 7;
        const int total = __builtin_amdgcn_readfirstlane(pfx8[x * 33 + 32]);
        for (;;) {
            if (wv == 0 && lane_opaque() == 0) itemw[0] = (int)atomicAdd(qctr + 64 * x, 1u);
            __syncthreads();
            const int it = __builtin_amdgcn_readfirstlane(itemw[0]);
            if (it >= total) break;
            int lo = 0, hi = 31;
            while (lo < hi) { const int mid = (lo + hi + 1) >> 1; if (pfx8[x * 33 + mid] <= it) lo = mid; else hi = mid - 1; }
            const int rk = __builtin_amdgcn_readfirstlane(lo), j = __builtin_amdgcn_readfirstlane(ord8[x * 32 + rk]), e = 8 * j + x, ch = it - __builtin_amdgcn_readfirstlane(pfx8[x * 33 + rk]);
            const int ne = __builtin_amdgcn_readfirstlane((int)cnt[e]), nch = __builtin_amdgcn_readfirstlane(nchs[e]);
            const int rpc = (((ne + nch - 1) / nch) + 31) & ~31, r0 = ch * rpc, nrows = min(rpc, ne - r0), nrt = (nrows + 31) >> 5;
            {
                const int tid = wv * 64 + lane_opaque();
                if (tid < 256) { const int a = list[(size_t)e * LCAP + r0 + min(tid, nrows - 1)]; rowasg[tid] = a; rowgate[tid] = gatebuf[a]; ((LAS int*)(lds + L4_YOFF))[tid] = (tid < nrows ? a : NTOK * 8) * (DM * 2); }
            }
            __syncthreads();
            if (nrt <= 4) p4_item<4>(p, lds, e, nrows, wv, vcu);
            else if (nrt <= 6) p4_item<6>(p, lds, e, nrows, wv, vcu);
            else p4_item<8>(p, lds, e, nrows, wv, vcu);
        }
        __syncthreads();
    }
}

DI void phase5(const Params& p, int vcu, int G, int wid) {
    const bf16* ybuf = (const bf16*)(p.ws + WS_Y);
    const int gtid = vcu * NTHR + tid_of(wid), gth = G * NTHR;
    for (int i = gtid; i < NTOK * (DM / 8); i += gth) {
        const int tok = i >> 7, n = (i & 127) * 8, b = tok / SEQ;
        float s[8];
#pragma unroll
        for (int e = 0; e < 8; ++e) s[e] = 0.f;
#pragma unroll
        for (int k = 0; k < 8; ++k) {
            const bf16x8 v = *(const bf16x8*)(ybuf + ((size_t)tok * 8 + k) * DM + n);
#pragma unroll
            for (int e = 0; e < 8; ++e) s[e] += (float)v[e];
        }
        float* op = p.out + (size_t)tok * DM + n;
        f32x4 o0 = *(f32x4*)op, o1 = *(f32x4*)(op + 4);
        const float* gm = (const float*)(p.ws + WS_MODF) + b * 6144 + 5 * DM + n;
        const f32x4 g0 = *(const f32x4*)gm, g1 = *(const f32x4*)(gm + 4);
#pragma unroll
        for (int e = 0; e < 4; ++e) { o0[e] += g0[e] * s[e]; o1[e] += g1[e] * s[4 + e]; }
        *(f32x4*)op = o0; *(f32x4*)(op + 4) = o1;
    }
}

DI int vcu_of(int bx, int G) { return (G % 8 == 0) ? (bx % 8) * (G / 8) + bx / 8 : bx; }
#if FUSED
__global__ void __launch_bounds__(NTHR) mk_fwd(Params p) {
    extern __shared__ __attribute__((aligned(16))) unsigned char lds_raw[];
    LAS char* lds = (LAS char*)lds_raw;
    const int G = gridDim.x, vcu = vcu_of(blockIdx.x, G);
    const int wid = __builtin_amdgcn_readfirstlane((int)threadIdx.x >> 6);
    volatile LAS unsigned* st = (volatile LAS unsigned*)(lds + LDS_BARW);
    if (tid_of(wid) == 0) { st[0] = 0u; st[1] = 0u; }
    __syncthreads();
    XcdBarrier bar = xcd_barrier_post((unsigned*)(p.ws + WS_CTL), st, wid);
    phase0(p, lds, vcu, G, wid);
    xcd_barrier(bar);
    if (REP == 0) { phase0(p, lds, vcu, G, wid); xcd_barrier(bar); }
    phase1(p, lds, vcu, wid);
    xcd_barrier(bar);
    if (REP == 1) { phase1(p, lds, vcu, wid); xcd_barrier(bar); }
    phase2(p, lds, vcu, G, wid);
    xcd_barrier(bar);
    if (REP == 2) { phase2(p, lds, vcu, G, wid); xcd_barrier(bar); }
    phase3(p, lds, vcu, wid);
    xcd_barrier(bar);
    phase4(p, lds, vcu, G, wid, (unsigned*)(p.ws + WS_CTL + CTL_Q));
    xcd_barrier(bar);
    if (REP == 4) { phase4(p, lds, vcu, G, wid, (unsigned*)(p.ws + WS_CTL + CTL_Q + 2048)); xcd_barrier(bar); }
    phase5(p, vcu, G, wid);
}
#else
#define LDSDECL extern __shared__ __attribute__((aligned(16))) unsigned char lds_raw[]; LAS char* lds = (LAS char*)lds_raw; const int G = gridDim.x, vcu = vcu_of(blockIdx.x, G); const int wid = __builtin_amdgcn_readfirstlane((int)threadIdx.x >> 6); (void)lds; (void)vcu;
__global__ void __launch_bounds__(NTHR) k_p0(Params p) { LDSDECL phase0(p, lds, vcu, G, wid); }
__global__ void __launch_bounds__(NTHR) k_p1(Params p) { LDSDECL phase1(p, lds, vcu, wid); }
__global__ void __launch_bounds__(NTHR) k_p2(Params p) { LDSDECL phase2(p, lds, vcu, G, wid); }
__global__ void __launch_bounds__(NTHR) k_p3(Params p) { LDSDECL phase3(p, lds, vcu, wid); }
__global__ void __launch_bounds__(NTHR) k_p4(Params p) { LDSDECL phase4(p, lds, vcu, G, wid, (unsigned*)(p.ws + WS_CTL + CTL_Q)); }
__global__ void __launch_bounds__(NTHR) k_p5(Params p) { LDSDECL phase5(p, vcu, G, wid); }
#endif

extern "C" void kernel_launch(void* const* d_in, const int* in_sizes, int n_in, void* d_out, int out_size, void* d_ws, size_t ws_size, hipStream_t stream) {
    if (n_in != 24 || ws_size < WS_END) { fprintf(stderr, "kernel_launch: unexpected inputs (n_in %d, ws %zu < %zu)\n", n_in, ws_size, (size_t)WS_END); return; }
    Params p{};
    p.x = (const float*)d_in[0]; p.c = (const float*)d_in[1]; p.pos = (const int*)d_in[2];
    p.w_ada = (const float*)d_in[3]; p.b_ada = (const float*)d_in[4]; p.g_mix = (const float*)d_in[5]; p.w_in = (const float*)d_in[6];
    p.g_q_a = (const float*)d_in[7]; p.g_k_a = (const float*)d_in[8]; p.sinks = (const float*)d_in[9]; p.g_q_b = (const float*)d_in[10]; p.g_k_b = (const float*)d_in[11];
    p.g_out_a = (const float*)d_in[12]; p.g_out_b = (const float*)d_in[13]; p.w_out = (const float*)d_in[14]; p.g_ffn = (const float*)d_in[15];
    p.w_router = (const float*)d_in[16]; p.r_bias = (const float*)d_in[17]; p.w_gate_e = (const float*)d_in[18]; p.w_up_e = (const float*)d_in[19]; p.w_down_e = (const float*)d_in[20];
    p.w_gate_s = (const float*)d_in[21]; p.w_up_s = (const float*)d_in[22]; p.w_down_s = (const float*)d_in[23];
    p.out = (float*)d_out; p.ws = (unsigned char*)d_ws;
    hipMemsetAsync((char*)d_ws + WS_CTL, 0, CTL_BYTES, stream);
    const int G = 256;
#if FUSED
    static bool attr_done = false;
    if (!attr_done) { hipFuncSetAttribute((const void*)mk_fwd, hipFuncAttributeMaxDynamicSharedMemorySize, LDS_BYTES); attr_done = true; }
    void* args[] = { &p };
    hipError_t e = hipLaunchCooperativeKernel((const void*)mk_fwd, dim3(G), dim3(NTHR), args, LDS_BYTES, stream);
    if (e != hipSuccess) fprintf(stderr, "cooperative launch failed: %s\n", hipGetErrorString(e));
#else
    static bool attr_done = false;
    if (!attr_done) {
        hipFuncSetAttribute((const void*)k_p0, hipFuncAttributeMaxDynamicSharedMemorySize, LDS_BYTES);
        hipFuncSetAttribute((const void*)k_p1, hipFuncAttributeMaxDynamicSharedMemorySize, LDS_BYTES);
        hipFuncSetAttribute((const void*)k_p2, hipFuncAttributeMaxDynamicSharedMemorySize, LDS_BYTES);
        hipFuncSetAttribute((const void*)k_p3, hipFuncAttributeMaxDynamicSharedMemorySize, LDS_BYTES);
        hipFuncSetAttribute((const void*)k_p4, hipFuncAttributeMaxDynamicSharedMemorySize, LDS_BYTES);
        hipFuncSetAttribute((const void*)k_p5, hipFuncAttributeMaxDynamicSharedMemorySize, LDS_BYTES);
        attr_done = true;
    }
    hipLaunchKernelGGL(k_p0, dim3(G), dim3(NTHR), LDS_BYTES, stream, p);
    hipLaunchKernelGGL(k_p1, dim3(G), dim3(NTHR), LDS_BYTES, stream, p);
    hipLaunchKernelGGL(k_p2, dim3(G), dim3(NTHR), LDS_BYTES, stream, p);
    hipLaunchKernelGGL(k_p3, dim3(G), dim3(NTHR), LDS_BYTES, stream, p);
    hipLaunchKernelGGL(k_p4, dim3(G), dim3(NTHR), LDS_BYTES, stream, p);
    hipLaunchKernelGGL(k_p5, dim3(G), dim3(NTHR), LDS_BYTES, stream, p);
#endif
}
```

```cpp
#include <hip/hip_runtime.h>
#include <stdint.h>
#include <cstdio>

#ifndef FUSED
#define FUSED 1
#endif
#ifndef REP
#define REP -1
#endif

typedef __bf16 bf16;
typedef __attribute__((ext_vector_type(8))) __bf16 bf16x8;
typedef __attribute__((ext_vector_type(4))) __bf16 bf16x4;
typedef __attribute__((ext_vector_type(16))) float f32x16;
typedef __attribute__((ext_vector_type(4))) float f32x4;
typedef __attribute__((ext_vector_type(4))) short s16x4;
typedef __attribute__((ext_vector_type(8))) short s16x8;
#define LAS __attribute__((address_space(3)))
#define DI __device__ __forceinline__
#define MFMA32(a, b, c) __builtin_amdgcn_mfma_f32_32x32x16_bf16((a), (b), (c), 0, 0, 0)

constexpr int NB = 8, SEQ = 2048, DM = 1024, NTOK = NB * SEQ, INW = 2304;
constexpr int KA_OFF = 512, VA_OFF = 640, QB_OFF = 768, KB_OFF = 1280, VB_OFF = 1792;
constexpr int NE = 256, ED = 256, LCAP = NTOK;
constexpr float EPS = 1e-6f;
constexpr int NTHR = 512, NWAVE = 8;
constexpr int PITCH = 2064;
constexpr int LDS_BYTES = 163840;
constexpr int LDS_MISC = 64 * PITCH;
constexpr int LDS_BARW = LDS_BYTES - 16;

constexpr size_t WS_CTL = 0;
constexpr size_t CTL_BYTES = 65536;
constexpr size_t CTL_CNT = 32768;
constexpr size_t CTL_Q = 40960;
constexpr size_t WS_MODP = WS_CTL + CTL_BYTES;
constexpr size_t WS_MODF = WS_MODP + 8ull * 8 * 6144 * 4;
constexpr size_t WS_ROPE = WS_MODF + 8ull * 6144 * 4;
constexpr size_t WS_WIN = WS_ROPE + 2ull * NTOK * 8 * 4;
constexpr size_t WS_WOUT = WS_WIN + (size_t)INW * DM * 2;
constexpr size_t WS_WR = WS_WOUT + (size_t)DM * DM * 2;
constexpr size_t WS_WGS = WS_WR + (size_t)NE * DM * 2;
constexpr size_t WS_WUS = WS_WGS + (size_t)256 * DM * 2;
constexpr size_t WS_WDS = WS_WUS + (size_t)256 * DM * 2;
constexpr size_t WS_QKV = WS_WDS + (size_t)256 * DM * 2;
constexpr size_t WS_OA = WS_QKV + (size_t)NTOK * INW * 2;
constexpr size_t WS_OB = WS_OA + (size_t)NTOK * 512 * 2;
constexpr size_t WS_LSE = WS_OB + 3ull * NTOK * 512 * 2;
constexpr size_t WS_H2 = WS_LSE + 3ull * NTOK * 8 * 4;
constexpr size_t WS_LOG = WS_H2 + (size_t)NTOK * DM * 2;
constexpr size_t WS_GATE = WS_LOG + (size_t)NTOK * NE * 4;
constexpr size_t WS_LIST = WS_GATE + (size_t)NTOK * 8 * 4;
constexpr size_t WS_Y = WS_LIST + (size_t)NE * LCAP * 4;
constexpr int YSH0 = NTOK * 8 + 1;
constexpr size_t WS_SG = WS_Y + ((size_t)NTOK * 9 + 1) * DM * 2;
constexpr size_t WS_END = WS_SG + 256ull * 8 * 16 * 64 * 16;

struct Params {
    const float *x, *c; const int* pos;
    const float *w_ada, *b_ada, *g_mix, *w_in, *g_q_a, *g_k_a, *sinks, *g_q_b, *g_k_b, *g_out_a, *g_out_b, *w_out, *g_ffn, *w_router, *r_bias;
    const float *w_gate_e, *w_up_e, *w_down_e, *w_gate_s, *w_up_s, *w_down_s;
    float* out; unsigned char* ws;
};

DI float shx(float v, int mask, int lane) { return __builtin_bit_cast(float, __builtin_amdgcn_ds_bpermute((lane ^ mask) << 2, __builtin_bit_cast(int, v))); }
DI int shxi(int v, int mask, int lane) { return __builtin_amdgcn_ds_bpermute((lane ^ mask) << 2, v); }
DI float shidx(float v, int src, int lane) { (void)lane; return __builtin_bit_cast(float, __builtin_amdgcn_ds_bpermute(src << 2, __builtin_bit_cast(int, v))); }
DI float wave_sum(float v, int lane) {
#pragma unroll
    for (int o = 1; o < 64; o <<= 1) v += shx(v, o, lane);
    return v;
}
DI int lane_opaque() { int l = (int)__builtin_amdgcn_mbcnt_hi(~0u, __builtin_amdgcn_mbcnt_lo(~0u, 0u)); asm volatile("" : "+v"(l)); return l; }
DI int wid_opaque(int wid) { int w = wid; asm volatile("" : "+s"(w)); return w; }
DI int tid_of(int wid) { return wid_opaque(wid) * 64 + lane_opaque(); }
DI float butterfly32(float (&q)[32], int lane) {
#pragma unroll
    for (int step = 0; step < 5; ++step) {
        const int m = 16 >> step;
        const bool up = (lane & m) != 0;
#pragma unroll
        for (int k = 0; k < m; ++k) { const float a = q[k], b = q[k + m]; const float send = up ? a : b, keep = up ? b : a; q[k] = keep + shx(send, m, lane); }
    }
    return q[0];
}
DI int crow(int r, int h) { return (r & 3) + 8 * (r >> 2) + 4 * h; }
DI float silu_f(float v) { return v * __builtin_amdgcn_rcpf(1.f + __expf(-v)); }
DI float mod_val(const Params& p, int b, int idx) {
    const float* mp = (const float*)(p.ws + WS_MODP);
    float s = p.b_ada[idx];
#pragma unroll
    for (int ks = 0; ks < 8; ++ks) s += mp[(size_t)(ks * 8 + b) * 6144 + idx];
    return s;
}
DI bf16x4 pack4(float a, float b, float c, float d) { bf16x4 v; v[0] = (bf16)a; v[1] = (bf16)b; v[2] = (bf16)c; v[3] = (bf16)d; return v; }

#define XB_TMO      128
#define XB_XCNT(j)  (256  + 64 * (j))
#define XB_XSUB(j)  (1280 + 64 * (j))
#define XB_XGEN(j)  (2304 + 64 * (j))
#define XB_TOP      3328
#define XB_TOPGEN   3392
#define XCD_BAR_WORDS 3456
#define XB_SPIN_CAP (1u << 22)
DI unsigned xb_ld(unsigned* p) { return __hip_atomic_load(p, __ATOMIC_RELAXED, __HIP_MEMORY_SCOPE_AGENT); }
DI unsigned xb_add(unsigned* p, unsigned v) { return __hip_atomic_fetch_add(p, v, __ATOMIC_RELAXED, __HIP_MEMORY_SCOPE_AGENT); }
DI unsigned xb_xcc_id() { return (unsigned)__builtin_amdgcn_s_getreg((3 << 11) | 20) & 0xFu; }
#define XB_SPIN(cond, bar) do { unsigned _sp = 0; while (cond) { __builtin_amdgcn_s_sleep(1); \
    if ((++_sp & 255u) == 0u) { if (xb_ld(&(bar)[XB_TMO])) break; if (_sp > XB_SPIN_CAP) { atomicAdd(&(bar)[XB_TMO], 1u); break; } } } } while (0)
struct XcdBarrier { unsigned* bar; unsigned x; volatile LAS unsigned* st; int wid; };
DI XcdBarrier xcd_barrier_post(unsigned* bar, volatile LAS unsigned* st, int wid) {
    XcdBarrier b; b.bar = bar; b.x = xb_xcc_id(); b.st = st; b.wid = wid;
    if (tid_of(wid) == 0) (void)xb_add(&bar[XB_XCNT(b.x)], 1u);
    return b;
}
DI void xcd_barrier_complete(unsigned* bar, unsigned x, unsigned& nloc, unsigned& nx) {
    const unsigned G = gridDim.x * gridDim.y * gridDim.z;
    unsigned sum, cnt, mine, sp = 0u;
    for (;;) {
        sum = 0u; cnt = 0u; mine = 0u;
#pragma unroll
        for (unsigned j = 0; j < 16; ++j) { const unsigned c = xb_ld(&bar[XB_XCNT(j)]); sum += c; cnt += (c > 0u) ? 1u : 0u; mine = (j == x) ? c : mine; }
        if (sum == G) break;
        __builtin_amdgcn_s_sleep(1);
        if ((++sp & 255u) == 0u) { if (xb_ld(&bar[XB_TMO])) break; if (sp > XB_SPIN_CAP) { atomicAdd(&bar[XB_TMO], 1u); break; } }
    }
    nloc = mine > 0u ? mine : 1u; nx = cnt > 0u ? cnt : 1u;
}
DI void xcd_barrier(const XcdBarrier& b) {
    asm volatile("s_waitcnt vmcnt(0)" ::: "memory");
    __syncthreads();
    if (tid_of(b.wid) == 0) {
        unsigned* bar = b.bar;
        __builtin_amdgcn_s_waitcnt(0);
        unsigned nloc = b.st[0], nx = b.st[1];
        if (nloc == 0u) { xcd_barrier_complete(bar, b.x, nloc, nx); b.st[0] = nloc; b.st[1] = nx; }
        const unsigned old = xb_add(&bar[XB_XSUB(b.x)], 1u);
        const unsigned gen = old / nloc;
        if (old + 1u == (gen + 1u) * nloc) {
            __builtin_amdgcn_fence(__ATOMIC_RELEASE, "agent");
            asm volatile("s_waitcnt vmcnt(0)" ::: "memory");
            const unsigned og = xb_add(&bar[XB_TOP], 1u);
            const unsigned tg = og / nx;
            if (og + 1u == (tg + 1u) * nx) xb_add(&bar[XB_TOPGEN], 1u);
            else XB_SPIN(xb_ld(&bar[XB_TOPGEN]) == tg, bar);
            __builtin_amdgcn_fence(__ATOMIC_ACQUIRE, "agent");
            xb_add(&bar[XB_XGEN(b.x)], 1u);
            asm volatile("s_waitcnt vmcnt(0)" ::: "memory");
        } else {
            XB_SPIN(xb_ld(&bar[XB_XGEN(b.x)]) == gen, bar);
            __builtin_amdgcn_fence(__ATOMIC_ACQUIRE, "agent");
            asm volatile("s_waitcnt vmcnt(0)" ::: "memory");
        }
    }
    __syncthreads();
}

template <int NT, int KS, bool CL = false>
DI void gemm_ct(f32x16 (&acc)[NT][2], const bf16x8* const (&wp)[NT], const LAS char* panel, int pitch, int lane) {
    const LAS char* b0 = panel + (lane & 31) * pitch + (lane >> 5) * 16;
    const LAS char* b1 = b0 + 32 * pitch;
    constexpr int PF = (NT >= 4) ? 2 : 4;
    bf16x8 w[PF][NT];
#pragma unroll
    for (int q = 0; q < PF; ++q)
#pragma unroll
        for (int i = 0; i < NT; ++i) w[q][i] = wp[i][q * 64];
#pragma unroll 1
    for (int ks0 = 0; ks0 < KS; ks0 += PF) {
#pragma unroll
        for (int q = 0; q < PF; ++q) {
            const int ks = ks0 + q;
            bf16x8 a[NT];
#pragma unroll
            for (int i = 0; i < NT; ++i) a[i] = w[q][i];
#pragma unroll
            for (int i = 0; i < NT; ++i) w[q][i] = wp[i][((ks + PF) & (KS - 1)) * 64];
            const bf16x8 t0 = *(const LAS bf16x8*)(b0 + ks * 32);
            const bf16x8 t1 = *(const LAS bf16x8*)(b1 + ks * 32);
#pragma unroll
            for (int i = 0; i < NT; ++i) {
                if (CL) { acc[i][0] = MFMA32(t0, a[i], acc[i][0]); acc[i][1] = MFMA32(t1, a[i], acc[i][1]); }
                else    { acc[i][0] = MFMA32(a[i], t0, acc[i][0]); acc[i][1] = MFMA32(a[i], t1, acc[i][1]); }
            }
            __builtin_amdgcn_sched_barrier(0);
        }
    }
}
template <int NT> DI void zero_acc(f32x16 (&acc)[NT][2]) {
#pragma unroll
    for (int i = 0; i < NT; ++i)
#pragma unroll
        for (int t = 0; t < 2; ++t)
#pragma unroll
            for (int r = 0; r < 16; ++r) acc[i][t][r] = 0.f;
}

struct CvtM { const float* W; bf16x8* dst; const float* sa; const float* sb; int K, N, il4, base; };
DI void cvt_decode(const Params& p, int pc, CvtM& m) {
    constexpr int P_IN = (INW / 32) * 64 * 64, P_OUT = 32 * 64 * 64, P_S = 8 * 64 * 64, P_D = 32 * 16 * 64;
    m.sa = nullptr; m.sb = nullptr; m.il4 = 0; m.K = DM;
    if (pc < P_IN) { m.W = p.w_in; m.dst = (bf16x8*)(p.ws + WS_WIN); m.N = INW; m.base = 0; return; }
    if (pc < P_IN + P_OUT) { m.W = p.w_out; m.dst = (bf16x8*)(p.ws + WS_WOUT); m.N = DM; m.base = P_IN; m.sa = p.g_out_a; m.sb = p.g_out_b; m.il4 = 1; return; }
    if (pc < P_IN + P_OUT + P_S) { m.W = p.w_router; m.dst = (bf16x8*)(p.ws + WS_WR); m.N = NE; m.base = P_IN + P_OUT; return; }
    if (pc < P_IN + P_OUT + 2 * P_S) { m.W = p.w_gate_s; m.dst = (bf16x8*)(p.ws + WS_WGS); m.N = 256; m.base = P_IN + P_OUT + P_S; return; }
    if (pc < P_IN + P_OUT + 3 * P_S) { m.W = p.w_up_s; m.dst = (bf16x8*)(p.ws + WS_WUS); m.N = 256; m.base = P_IN + P_OUT + 2 * P_S; return; }
    m.W = p.w_down_s; m.dst = (bf16x8*)(p.ws + WS_WDS); m.N = DM; m.K = 256; m.base = P_IN + P_OUT + 3 * P_S; m.il4 = 1;
}
constexpr int CVT_TOTAL = (INW / 32) * 64 * 64 + 32 * 64 * 64 + 3 * 8 * 64 * 64 + 32 * 16 * 64;
DI void phase0(const Params& p, LAS char* lds, int vcu, int G, int wid) {
    const int lane = lane_opaque(), wv = wid_opaque(wid), tid = wv * 64 + lane;
    const int gtid = vcu * NTHR + tid, gth = G * NTHR;
    float wa[3][16]; int a_cc[3], a_ks[3];
#pragma unroll
    for (int m = 0; m < 3; ++m) {
        const int it = vcu + G * m; a_cc[m] = it % 96; a_ks[m] = (it / 96) & 7;
        const float* wp = p.w_ada + (size_t)(128 * a_ks[m] + 16 * wv) * 6144 + 64 * a_cc[m] + lane;
#pragma unroll
        for (int i = 0; i < 16; ++i) wa[m][i] = (it < 768) ? wp[(size_t)i * 6144] : 0.f;
    }
    float lv[5][8];
#pragma unroll
    for (int i = 0; i < 5; ++i) {
        const int pc0 = gtid + i * gth, pc = pc0 < CVT_TOTAL ? pc0 : 0;
        CvtM cm; cvt_decode(p, pc, cm);
        const int q = pc - cm.base, KS = cm.K / 16, l = q & 63, ks = (q >> 6) % KS, nt = (q >> 6) / KS;
        const int n = cm.il4 ? 128 * (nt >> 2) + 4 * (l & 31) + (nt & 3) : 32 * nt + (l & 31), k0 = 16 * ks + 8 * (l >> 5);
#pragma unroll
        for (int j = 0; j < 8; ++j) lv[i][j] = cm.W[(size_t)(k0 + j) * cm.N + n];
    }
    {
        float* cosT = (float*)(p.ws + WS_ROPE); float* sinT = cosT + (size_t)NTOK * 8;
        for (int e = gtid; e < NTOK * 8; e += gth) {
            const int t = e >> 3, i = e & 7;
            const float inv = (float)exp2(-(double)i * 0.125 * 18.931568569324174);
            const float ang = (float)p.pos[t] * inv;
            double rev = (double)ang * 0.15915494309189535; rev -= floor(rev);
            cosT[e] = __builtin_amdgcn_cosf((float)rev);
            sinT[e] = __builtin_amdgcn_sinf((float)rev);
        }
    }
    LAS float* red = (LAS float*)lds;
    LAS float* cond = (LAS float*)(lds + 16384);
#pragma unroll
    for (int m = 0; m < 3; ++m) {
        const int it = vcu + G * m;
        if (it < 768) {
            { const int kl = tid >> 2, b2 = (tid & 3) * 2;
              cond[kl * 8 + b2] = silu_f(p.c[b2 * DM + 128 * a_ks[m] + kl]); cond[kl * 8 + b2 + 1] = silu_f(p.c[(b2 + 1) * DM + 128 * a_ks[m] + kl]); }
            __syncthreads();
            float acc[8];
#pragma unroll
            for (int b = 0; b < 8; ++b) acc[b] = 0.f;
#pragma unroll
            for (int i = 0; i < 16; ++i) {
                const f32x4 c0 = *(const LAS f32x4*)(cond + (16 * wv + i) * 8), c1 = *(const LAS f32x4*)(cond + (16 * wv + i) * 8 + 4);
#pragma unroll
                for (int b = 0; b < 4; ++b) { acc[b] += c0[b] * wa[m][i]; acc[4 + b] += c1[b] * wa[m][i]; }
            }
#pragma unroll
            for (int b = 0; b < 8; ++b) red[(wv * 8 + b) * 64 + lane] = acc[b];
            __syncthreads();
            {
                const int b = tid >> 6, col = tid & 63;
                float s2 = 0.f;
#pragma unroll
                for (int w8 = 0; w8 < 8; ++w8) s2 += red[(w8 * 8 + b) * 64 + col];
                ((float*)(p.ws + WS_MODP))[(size_t)(a_ks[m] * 8 + b) * 6144 + 64 * a_cc[m] + col] = s2;
            }
            __syncthreads();
        }
    }
#pragma unroll
    for (int i = 0; i < 5; ++i) {
        const int pc = vcu * NTHR + wv * 64 + lane_opaque() + i * gth;
        if (pc < CVT_TOTAL) {
            CvtM cm; cvt_decode(p, pc, cm);
            const int q = pc - cm.base, KS = cm.K / 16, l = q & 63, ks = (q >> 6) % KS, k0 = 16 * ks + 8 * (l >> 5);
            bf16x8 v;
#pragma unroll
            for (int j = 0; j < 8; ++j) {
                float w = lv[i][j];
                if (cm.sa) { const int k = k0 + j; w *= (k < 512) ? cm.sa[k] : cm.sb[k - 512]; }
                v[j] = (bf16)w;
            }
            cm.dst[q] = v;
        }
    }
}

DI void phase1(const Params& p, LAS char* lds, int wg, int wid) {
    const int lane = lane_opaque(), wv = wid_opaque(wid), tid = wv * 64 + lane;
    const int t0 = wg * 64, b = t0 / SEQ;
    if (tid < 192) { const int idx = (wg & 31) * 192 + tid; ((float*)(p.ws + WS_MODF))[b * 6144 + idx] = mod_val(p, b, idx); }
    {
        float ga[16], sh[16];
#pragma unroll
        for (int j = 0; j < 4; ++j)
#pragma unroll
            for (int e = 0; e < 4; ++e) {
                const int k = 256 * j + 4 * lane + e;
                ga[4 * j + e] = p.g_mix[k] * (1.f + mod_val(p, b, 1 * DM + k));
                sh[4 * j + e] = mod_val(p, b, 0 * DM + k);
            }
#pragma unroll 1
        for (int i = 0; i < 8; ++i) {
            const int row = 8 * wv + i;
            const float* xr = p.x + (size_t)(t0 + row) * DM;
            f32x4 v[4]; float ss = 0.f;
#pragma unroll
            for (int j = 0; j < 4; ++j) { v[j] = *(const f32x4*)(xr + 256 * j + 4 * lane); ss += v[j][0] * v[j][0] + v[j][1] * v[j][1] + v[j][2] * v[j][2] + v[j][3] * v[j][3]; }
            const float rstd = rsqrtf(wave_sum(ss, lane) * (1.f / DM) + EPS);
#pragma unroll
            for (int j = 0; j < 4; ++j) {
                const bf16x4 o = pack4(v[j][0] * rstd * ga[4 * j] + sh[4 * j], v[j][1] * rstd * ga[4 * j + 1] + sh[4 * j + 1],
                                       v[j][2] * rstd * ga[4 * j + 2] + sh[4 * j + 2], v[j][3] * rstd * ga[4 * j + 3] + sh[4 * j + 3]);
                *(LAS bf16x4*)(lds + row * PITCH + (256 * j + 4 * lane) * 2) = o;
            }
        }
    }
    __syncthreads();
    const bf16x8* wsw = (const bf16x8*)(p.ws + WS_WIN);
    const float* cosT = (const float*)(p.ws + WS_ROPE); const float* sinT = cosT + (size_t)NTOK * 8;
    bf16* qkv = (bf16*)(p.ws + WS_QKV);
    const int h = lane >> 5;
#pragma unroll 1
    for (int u = wv; u < 36; u += NWAVE) {
        f32x16 acc[2][2]; zero_acc<2>(acc);
        const bf16x8* wp[2] = { wsw + (size_t)(2 * u) * 64 * 64 + lane, wsw + (size_t)(2 * u + 1) * 64 * 64 + lane };
        gemm_ct<2, 64>(acc, wp, lds, PITCH, lane);
        const float* g = nullptr; float qs = 1.f;
        if (u < 8) { g = p.g_q_a; qs = 0.125f; } else if (u < 10) g = p.g_k_a; else if (u >= 12 && u < 20) { g = p.g_q_b; qs = 0.125f; } else if (u >= 20 && u < 28) g = p.g_k_b;
#pragma unroll
        for (int tt = 0; tt < 2; ++tt) {
            const int tok = t0 + 32 * tt + (lane & 31);
            if (g) {
                float ss = 0.f;
#pragma unroll
                for (int nt = 0; nt < 2; ++nt)
#pragma unroll
                    for (int r = 0; r < 16; ++r) ss += acc[nt][tt][r] * acc[nt][tt][r];
                ss += shx(ss, 32, lane);
                const float rstd = rsqrtf(ss * (1.f / 64.f) + EPS);
#pragma unroll
                for (int nt = 0; nt < 2; ++nt)
#pragma unroll
                    for (int r = 0; r < 16; ++r) acc[nt][tt][r] *= rstd * g[32 * nt + crow(r, h)];
#pragma unroll
                for (int r = 0; r < 4; ++r) {
                    const int i = r + 4 * h;
                    const float cs = cosT[(size_t)tok * 8 + i], sn = sinT[(size_t)tok * 8 + i];
                    const float a1 = acc[0][tt][r], a2 = acc[0][tt][r + 4];
                    acc[0][tt][r] = a1 * cs - a2 * sn; acc[0][tt][r + 4] = a2 * cs + a1 * sn;
                }
            }
#pragma unroll
            for (int nt = 0; nt < 2; ++nt)
#pragma unroll
                for (int g4 = 0; g4 < 4; ++g4) {
                    const bf16x4 o = pack4(acc[nt][tt][4 * g4] * qs, acc[nt][tt][4 * g4 + 1] * qs, acc[nt][tt][4 * g4 + 2] * qs, acc[nt][tt][4 * g4 + 3] * qs);
                    *(bf16x4*)(qkv + (size_t)tok * INW + 64 * u + 32 * nt + 8 * g4 + 4 * h) = o;
                }
        }
    }
}

constexpr int VP = 192;
DI void attn_unit(const Params& p, LAS char* vimg, int u, int lane) {
    const int combo = u & 31, blk = (u >> 5) & 31, b = u >> 10;
    const int h = lane >> 5, l31 = lane & 31;
    int qoff, koff, voff, dil, maxd; float m_init, l_init; bf16* outp; float* lsep = nullptr; int hb;
    if (combo < 8) {
        hb = combo; qoff = 64 * hb; koff = KA_OFF + 64 * (hb >> 2); voff = VA_OFF + 64 * (hb >> 2); dil = 1; maxd = 127;
        m_init = p.sinks[hb]; l_init = 1.f; outp = (bf16*)(p.ws + WS_OA);
    } else {
        const int br = (combo - 8) >> 3; hb = (combo - 8) & 7;
        qoff = QB_OFF + 64 * hb; koff = KB_OFF + 64 * hb; voff = VB_OFF + 64 * hb; dil = (br == 0) ? 1 : (br == 1 ? 4 : 16); maxd = 128;
        m_init = -1e30f; l_init = 0.f; outp = (bf16*)(p.ws + WS_OB) + (size_t)br * NTOK * 512; lsep = (float*)(p.ws + WS_LSE) + (size_t)br * NTOK * 8;
    }
    const int L = SEQ / dil, nb = L / 64, rho = blk / nb, l0 = (blk % nb) * 64;
    const bf16* qkv = (const bf16*)(p.ws + WS_QKV) + (size_t)b * SEQ * INW;
    bf16x8 qf[2][4];
#pragma unroll
    for (int qt = 0; qt < 2; ++qt) {
        const bf16* qp = qkv + (size_t)((l0 + 32 * qt + l31) * dil + rho) * INW + qoff + 8 * h;
#pragma unroll
        for (int s = 0; s < 4; ++s) qf[qt][s] = *(const bf16x8*)(qp + 16 * s);
    }
    f32x16 o[2][2];
#pragma unroll
    for (int dt = 0; dt < 2; ++dt)
#pragma unroll
        for (int qt = 0; qt < 2; ++qt)
#pragma unroll
            for (int r = 0; r < 16; ++r) o[dt][qt][r] = 0.f;
    float mrun[2] = { m_init, m_init }, lrun[2] = { h == 0 ? l_init : 0.f, h == 0 ? l_init : 0.f };
    const float LOG2E = 1.4426950408889634f;
#pragma unroll 1
    for (int kt = 0; kt < 6; ++kt) {
        const int lk0 = l0 - 128 + 32 * kt;
        if (lk0 + 31 < 0) continue;
        bf16x8 kf[4];
        {
            int lk = lk0 + l31; lk = lk < 0 ? 0 : lk;
            const bf16* kp = qkv + (size_t)(lk * dil + rho) * INW + koff + 8 * h;
#pragma unroll
            for (int s = 0; s < 4; ++s) kf[s] = *(const bf16x8*)(kp + 16 * s);
        }
        {
            bf16x8 vr[4];
#pragma unroll
            for (int i = 0; i < 4; ++i) {
                int lk = lk0 + (lane >> 3) + 8 * i; lk = lk < 0 ? 0 : lk;
                vr[i] = *(const bf16x8*)(qkv + (size_t)(lk * dil + rho) * INW + voff + 8 * (lane & 7));
            }
#pragma unroll
            for (int i = 0; i < 4; ++i) *(LAS bf16x8*)(vimg + ((lane >> 3) + 8 * i) * VP + 16 * (lane & 7)) = vr[i];
        }
        bf16x8 vf[2][2];
        {
            const int g1 = (lane >> 4) & 1, q4 = (lane & 15) >> 2, p4 = lane & 3;
#pragma unroll
            for (int dt = 0; dt < 2; ++dt)
#pragma unroll
                for (int s = 0; s < 2; ++s) {
                    const LAS char* a0 = vimg + (16 * s + 4 * h + q4) * VP + (32 * dt + 16 * g1 + 4 * p4) * 2;
                    const s16x4 lo = __builtin_amdgcn_ds_read_tr16_b64_v4i16((LAS s16x4*)a0);
                    const s16x4 hi = __builtin_amdgcn_ds_read_tr16_b64_v4i16((LAS s16x4*)(a0 + 8 * VP));
                    const s16x8 c = __builtin_shufflevector(lo, hi, 0, 1, 2, 3, 4, 5, 6, 7);
                    vf[dt][s] = __builtin_bit_cast(bf16x8, c);
                }
        }
#pragma unroll
        for (int qt = 0; qt < 2; ++qt) {
            if ((qt == 0 && kt == 5) || (qt == 1 && kt == 0)) continue;
            f32x16 sacc;
#pragma unroll
            for (int r = 0; r < 16; ++r) sacc[r] = 0.f;
#pragma unroll
            for (int s = 0; s < 4; ++s) sacc = MFMA32(kf[s], qf[qt][s], sacc);
            const int lq = l0 + 32 * qt + l31;
            float mx = -1e30f;
#pragma unroll
            for (int r = 0; r < 16; ++r) {
                const int lk = lk0 + crow(r, h), d = lq - lk;
                const bool ok = (lk >= 0) && (d >= 0) && (d <= maxd);
                sacc[r] = ok ? sacc[r] : -1e30f;
                mx = fmaxf(mx, sacc[r]);
            }
            mx = fmaxf(mx, shx(mx, 32, lane));
            const float mnew = fmaxf(mrun[qt], mx);
            const float alpha = exp2f((mrun[qt] - mnew) * LOG2E);
            float ps = 0.f;
#pragma unroll
            for (int r = 0; r < 16; ++r) { sacc[r] = exp2f((sacc[r] - mnew) * LOG2E); ps += sacc[r]; }
            lrun[qt] = lrun[qt] * alpha + ps; mrun[qt] = mnew;
#pragma unroll
            for (int dt = 0; dt < 2; ++dt)
#pragma unroll
                for (int r = 0; r < 16; ++r) o[dt][qt][r] *= alpha;
            bf16x8 pf[2];
#pragma unroll
            for (int s = 0; s < 2; ++s)
#pragma unroll
                for (int j = 0; j < 8; ++j) pf[s][j] = (bf16)sacc[8 * s + j];
#pragma unroll
            for (int dt = 0; dt < 2; ++dt)
#pragma unroll
                for (int s = 0; s < 2; ++s) o[dt][qt] = MFMA32(vf[dt][s], pf[s], o[dt][qt]);
        }
    }
#pragma unroll
    for (int qt = 0; qt < 2; ++qt) {
        const float lt = lrun[qt] + shx(lrun[qt], 32, lane);
        const float inv = 1.f / lt;
        const size_t tok = (size_t)b * SEQ + (size_t)(l0 + 32 * qt + l31) * dil + rho;
#pragma unroll
        for (int dt = 0; dt < 2; ++dt)
#pragma unroll
            for (int g4 = 0; g4 < 4; ++g4) {
                const bf16x4 v = pack4(o[dt][qt][4 * g4] * inv, o[dt][qt][4 * g4 + 1] * inv, o[dt][qt][4 * g4 + 2] * inv, o[dt][qt][4 * g4 + 3] * inv);
                *(bf16x4*)(outp + tok * 512 + 64 * hb + 32 * dt + 8 * g4 + 4 * h) = v;
            }
        if (lsep && h == 0) lsep[tok * 8 + hb] = mrun[qt] + logf(lt);
    }
}
DI void phase2(const Params& p, LAS char* lds, int vcu, int G, int wid) {
    const int lane = lane_opaque(), wv = wid_opaque(wid), tid = wv * 64 + lane;
    LAS char* vimg = lds + wv * (32 * VP);
    for (int u = vcu * NWAVE + wv; u < 8192; u += G * NWAVE) attn_unit(p, vimg, u, lane);
}

DI void phase3(const Params& p, LAS char* lds, int wg, int wid) {
    const int lane = lane_opaque(), wv = wid_opaque(wid), tid = wv * 64 + lane, h = lane >> 5, l31 = lane & 31;
    const int t0 = wg * 64, b = t0 / SEQ;
    LAS float* ga_l = (LAS float*)(lds + LDS_MISC + 2048);
    LAS float* hs_l = ga_l + 1024;
    LAS float* sh_l = hs_l + 1024;
    LAS float* gm_l = sh_l + 1024;
    LAS unsigned* lcnt = (LAS unsigned*)(lds + LDS_MISC + 18432 + 256);
    LAS unsigned* lbase = lcnt + 256;
    if (tid < NE) lcnt[tid] = 0u;
    {
        const float* mf = (const float*)(p.ws + WS_MODF) + b * 6144;
        for (int n = tid; n < DM; n += NTHR) { ga_l[n] = mf[2 * DM + n]; hs_l[n] = p.g_ffn[n] * (1.f + mf[4 * DM + n]); sh_l[n] = mf[3 * DM + n]; gm_l[n] = mf[5 * DM + n]; }
    }
    {
        const bf16* oa = (const bf16*)(p.ws + WS_OA); const bf16* ob = (const bf16*)(p.ws + WS_OB); const float* lse = (const float*)(p.ws + WS_LSE);
#pragma unroll 1
        for (int ib = 0; ib < 2; ++ib) {
            bf16x8 d[4][3][2]; float e3[4][3];
#pragma unroll
            for (int i = 0; i < 4; ++i) {
                const size_t tok = t0 + 8 * wv + 4 * ib + i;
                if (h == 0) {
                    d[i][0][0] = *(const bf16x8*)(oa + tok * 512 + 16 * l31); d[i][0][1] = *(const bf16x8*)(oa + tok * 512 + 16 * l31 + 8);
                } else {
                    const int hd = l31 >> 2;
#pragma unroll
                    for (int br = 0; br < 3; ++br) {
                        const bf16* src = ob + (size_t)br * NTOK * 512 + tok * 512 + 16 * l31;
                        d[i][br][0] = *(const bf16x8*)src; d[i][br][1] = *(const bf16x8*)(src + 8);
                        e3[i][br] = lse[(size_t)br * NTOK * 8 + tok * 8 + hd];
                    }
                }
            }
#pragma unroll
            for (int i = 0; i < 4; ++i) {
                const int row = 8 * wv + 4 * ib + i;
                float v[16];
                if (h == 0) {
#pragma unroll
                    for (int j = 0; j < 8; ++j) { v[j] = (float)d[i][0][0][j]; v[8 + j] = (float)d[i][0][1][j]; }
                } else {
                    const float mx = fmaxf(e3[i][0], fmaxf(e3[i][1], e3[i][2]));
                    float w0 = __expf(e3[i][0] - mx), w1 = __expf(e3[i][1] - mx), w2 = __expf(e3[i][2] - mx);
                    const float wi = 1.f / (w0 + w1 + w2); w0 *= wi; w1 *= wi; w2 *= wi;
#pragma unroll
                    for (int j = 0; j < 8; ++j) {
                        v[j] = w0 * (float)d[i][0][0][j] + w1 * (float)d[i][1][0][j] + w2 * (float)d[i][2][0][j];
                        v[8 + j] = w0 * (float)d[i][0][1][j] + w1 * (float)d[i][1][1][j] + w2 * (float)d[i][2][1][j];
                    }
                }
                float ss = 0.f;
#pragma unroll
                for (int j = 0; j < 16; ++j) ss += v[j] * v[j];
#pragma unroll
                for (int o2 = 1; o2 < 32; o2 <<= 1) ss += shx(ss, o2, lane);
                const float rstd = rsqrtf(ss * (1.f / 512.f) + EPS);
                bf16x8 o0, o1;
#pragma unroll
                for (int j = 0; j < 8; ++j) { o0[j] = (bf16)(v[j] * rstd); o1[j] = (bf16)(v[8 + j] * rstd); }
                LAS char* dst = lds + row * PITCH + (512 * h + 16 * l31) * 2;
                *(LAS bf16x8*)dst = o0; *(LAS bf16x8*)(dst + 16) = o1;
            }
        }
    }
    __syncthreads();
    f32x16 x1[4][2]; zero_acc<4>(x1);
    {
        const bf16x8* wsw = (const bf16x8*)(p.ws + WS_WOUT);
        const bf16x8* wp[4];
#pragma unroll
        for (int i = 0; i < 4; ++i) wp[i] = wsw + (size_t)(4 * wv + i) * 64 * 64 + lane;
        gemm_ct<4, 64, true>(x1, wp, lds, PITCH, lane);
    }
    LAS float* ssx = (LAS float*)(lds + LDS_MISC);
    LAS float* rsx = (LAS float*)(lds + LDS_MISC + 18432);
    {
        const int lane = lane_opaque(), h = lane >> 5, l31 = lane & 31, nb = 128 * wv + 4 * l31;
        const f32x4 ga4 = *(const LAS f32x4*)(ga_l + nb);
        float q[32];
#pragma unroll
        for (int tt = 0; tt < 2; ++tt)
#pragma unroll
            for (int r = 0; r < 16; ++r) {
                const size_t tok = t0 + 32 * tt + crow(r, h);
                const f32x4 xv = *(const f32x4*)(p.x + tok * DM + nb);
                f32x4 ov; float ss = 0.f;
#pragma unroll
                for (int e = 0; e < 4; ++e) { const float v = xv[e] + ga4[e] * x1[e][tt][r]; x1[e][tt][r] = v; ov[e] = v; ss += v * v; }
                *(f32x4*)(p.out + tok * DM + nb) = ov;
                q[16 * tt + r] = ss;
                if ((r & 7) == 7) __builtin_amdgcn_sched_barrier(0);
            }
        const float tot = butterfly32(q, lane);
        ssx[wv * 64 + 32 * (l31 >> 4) + crow(l31 & 15, h)] = tot;
    }
    __syncthreads();
    { const int tid2 = wv * 64 + lane_opaque();
      if (tid2 < 64) { float ss = 0.f;
#pragma unroll
        for (int w8 = 0; w8 < 8; ++w8) ss += ssx[w8 * 64 + tid2];
        rsx[tid2] = rsqrtf(ss * (1.f / DM) + EPS); } }
    __syncthreads();
    {
        const int lane = lane_opaque(), h = lane >> 5, l31 = lane & 31, nb = 128 * wv + 4 * l31;
        bf16* h2g = (bf16*)(p.ws + WS_H2);
        const f32x4 hs4 = *(const LAS f32x4*)(hs_l + nb), sh4 = *(const LAS f32x4*)(sh_l + nb);
#pragma unroll
        for (int tt = 0; tt < 2; ++tt)
#pragma unroll
            for (int r = 0; r < 16; ++r) {
                const int row = 32 * tt + crow(r, h); const size_t tok = t0 + row;
                const float rstd = rsx[row];
                const bf16x4 o = pack4(x1[0][tt][r] * rstd * hs4[0] + sh4[0], x1[1][tt][r] * rstd * hs4[1] + sh4[1], x1[2][tt][r] * rstd * hs4[2] + sh4[2], x1[3][tt][r] * rstd * hs4[3] + sh4[3]);
                *(LAS bf16x4*)(lds + row * PITCH + nb * 2) = o;
                *(bf16x4*)(h2g + tok * DM + nb) = o;
                if ((r & 3) == 3) __builtin_amdgcn_sched_barrier(0);
            }
    }
    __syncthreads();
    float* logit = (float*)(p.ws + WS_LOG);
    {
        f32x16 ra[1][2]; zero_acc<1>(ra);
        const bf16x8* wp[1] = { (const bf16x8*)(p.ws + WS_WR) + (size_t)wv * 64 * 64 + lane };
        gemm_ct<1, 64, true>(ra, wp, lds, PITCH, lane);
        const int lane = lane_opaque(), h = lane >> 5, l31 = lane & 31;
#pragma unroll
        for (int tt = 0; tt < 2; ++tt)
#pragma unroll
            for (int r = 0; r < 16; ++r) logit[(size_t)(t0 + 32 * tt + crow(r, h)) * NE + 32 * wv + l31] = ra[0][tt][r];
    }
    asm volatile("s_waitcnt vmcnt(0)" ::: "memory");
    __syncthreads();
    int k_exp, k_asg; unsigned k_lpos; float k_gate;
    {
        const int lane = lane_opaque(); int t0y = t0; asm volatile("" : "+s"(t0y));
        const int g = lane & 7; const size_t tok = t0y + 8 * wv + (lane >> 3);
        unsigned key[32];
        const float* lp = logit + tok * NE + 32 * g;
        float m1 = -INFINITY, m2 = -INFINITY;
#pragma unroll
        for (int j = 0; j < 8; ++j) {
            const f32x4 v = __builtin_nontemporal_load((const f32x4*)(lp + 4 * j));
            const f32x4 rb = *(const f32x4*)(p.r_bias + 32 * g + 4 * j);
#pragma unroll
            for (int e = 0; e < 4; ++e) {
                const float bv = __builtin_amdgcn_rcpf(1.f + __expf(-v[e])) + rb[e];
                key[4 * j + e] = (__float_as_uint(bv + 1.0f) & 0xFFFFFF00u) | (unsigned)(255 - (32 * g + 4 * j + e));
                const float hi = fmaxf(m1, bv), lo = fminf(m1, bv); m1 = hi; m2 = fmaxf(m2, lo);
            }
        }
        const float gs = m1 + m2;
        int rank = 0;
#pragma unroll
        for (int o2 = 0; o2 < 8; ++o2) { const float og = shidx(gs, (lane & ~7) | o2, lane); rank += (og > gs || (og == gs && o2 < g)) ? 1 : 0; }
        if (rank >= 4) {
#pragma unroll
            for (int j = 0; j < 32; ++j) key[j] = 0u;
        }
        unsigned mykey = 0u;
#pragma unroll 1
        for (int k = 0; k < 8; ++k) {
            unsigned kw = 0u;
#pragma unroll
            for (int j = 0; j < 32; ++j) kw = max(kw, key[j]);
#pragma unroll
            for (int o2 = 1; o2 < 8; o2 <<= 1) kw = max(kw, (unsigned)shxi((int)kw, o2, lane));
#pragma unroll
            for (int j = 0; j < 32; ++j) key[j] = (key[j] == kw) ? 0u : key[j];
            if (k == g) mykey = kw;
        }
        const int myexp = 255 - (int)(mykey & 0xFFu);
        const float myscore = __builtin_amdgcn_rcpf(1.f + __expf(-__builtin_nontemporal_load(logit + tok * NE + myexp)));
        float ssum = myscore;
#pragma unroll
        for (int o2 = 1; o2 < 8; o2 <<= 1) ssum += shx(ssum, o2, lane);
        const float gate = myscore / ssum * 2.5f;
        k_exp = myexp; k_gate = gate; k_asg = (int)tok * 8 + g;
        k_lpos = __hip_atomic_fetch_add(&lcnt[myexp], 1u, __ATOMIC_RELAXED, __HIP_MEMORY_SCOPE_WORKGROUP);
    }
    __syncthreads();
    unsigned k_gb = 0u;
    { const int tid2 = wv * 64 + lane_opaque();
      if (tid2 < NE) { const unsigned c = lcnt[tid2]; if (c) k_gb = atomicAdd((unsigned*)(p.ws + WS_CTL + CTL_CNT) + tid2, c); } }
    {
        const int tid2 = wv * 64 + lane_opaque();
        if (tid2 < NE) lbase[tid2] = k_gb;
        __syncthreads();
        const unsigned pos = lbase[k_exp] + k_lpos;
        ((int*)(p.ws + WS_LIST))[(size_t)k_exp * LCAP + pos] = k_asg;
        ((float*)(p.ws + WS_GATE))[k_asg] = k_gate;
    }
}

constexpr int EAP = 144;
constexpr int ACTP = 528;
constexpr int L4_ABUF = 0;
constexpr int L4_ACT = 0;
constexpr int L4_ROW = 135168;
constexpr int L4_GATE = L4_ROW + 1024;
constexpr int L4_YOFF = L4_GATE + 1024;
constexpr int L4_NCH = L4_YOFF + 1024;
constexpr int L4_PFX = L4_NCH + 1024;
constexpr int L4_ITEM = L4_PFX + 1040;
constexpr int L4_WSC = 141312;
constexpr int WSC_BYTES = 2560;
static_assert(L4_ITEM + 16 <= L4_WSC && L4_WSC + 8 * WSC_BYTES + 8 * 33 * 4 <= LDS_BARW, "P4 LDS layout");
struct WRaw { f32x4 v[2]; };
DI void load_wraw(WRaw& d, const float* base, int ld, int loff) {
    d.v[0] = *(const f32x4*)(base + loff);
    d.v[1] = *(const f32x4*)(base + (size_t)8 * ld + loff);
}
DI bf16x8 wfrag_from(const WRaw& d, LAS char* wsc, int lane) {
    const int wo = (lane >> 3) * 64 + (lane & 7) * 8;
    *(LAS bf16x4*)(wsc + wo) = pack4(d.v[0][0], d.v[0][1], d.v[0][2], d.v[0][3]);
    *(LAS bf16x4*)(wsc + wo + 512) = pack4(d.v[1][0], d.v[1][1], d.v[1][2], d.v[1][3]);
    const LAS char* ra = wsc + (8 * (lane >> 5) + ((lane & 15) >> 2)) * 64 + (16 * ((lane >> 4) & 1) + 4 * (lane & 3)) * 2;
    const s16x4 lo = __builtin_amdgcn_ds_read_tr16_b64_v4i16((LAS s16x4*)ra);
    const s16x4 hi = __builtin_amdgcn_ds_read_tr16_b64_v4i16((LAS s16x4*)(ra + 4 * 64));
    const s16x8 c = __builtin_shufflevector(lo, hi, 0, 1, 2, 3, 4, 5, 6, 7);
    return __builtin_bit_cast(bf16x8, c);
}
#ifndef PFW2
#define PFW2 4
#endif
#ifndef PFW
#define PFW 4
#endif
struct P4St { WRaw raw[4]; bf16x8 sa[4], sb[4]; };
DI void p4_issue(P4St& S, const float* wb, int loff, const bf16* h2g, const int (&roff)[4]) {
#pragma unroll
    for (int i = 0; i < 4; ++i) S.sa[i] = *(const bf16x8*)(h2g + roff[i]);
#pragma unroll
    for (int q = 0; q < 4; ++q) load_wraw(S.raw[q], wb + (size_t)q * 16 * ED, ED, loff);
#pragma unroll
    for (int i = 0; i < 4; ++i) S.sb[i] = *(const bf16x8*)(h2g + roff[i] + 64);
}
template <int NRT>
DI void p4_chunk(f32x16 (&acc)[NRT], P4St& S, bf16x8& wf, bf16x8 (&snew)[4], const bf16x8 (&swr_regs)[4], int kc, const float* wb, int loff, const bf16* h2g, const int (&roff)[4],
                 LAS char* lds, LAS char* wsc, int swr, int lane, int l31, int h) {
    {
        const int kn = (kc + 2) & 15;
#pragma unroll
        for (int i = 0; i < 4; ++i) snew[i] = *(const bf16x8*)(h2g + roff[i] + 64 * kn);
    }
    const int bcur = kc % 3, bnxt = (kc + 1) % 3;
    const LAS char* ab = lds + L4_ABUF + bcur * (256 * EAP) + l31 * EAP + 16 * h;
#pragma unroll
    for (int s = 0; s < 4; ++s) {
        const int ks = 4 * kc + s;
        const bf16x8 wfn = wfrag_from(S.raw[(s + 1) & 3], wsc, lane);
        load_wraw(S.raw[(s + 1) & 3], wb + (size_t)((ks + 5) & 63) * 16 * ED, ED, loff);
#pragma unroll
        for (int g = 0; g < NRT; g += 4) {
            bf16x8 bt[4];
#pragma unroll
            for (int rt = 0; rt < 4; ++rt) if (g + rt < NRT) bt[rt] = *(const LAS bf16x8*)(ab + (g + rt) * 32 * EAP + 32 * s);
#pragma unroll
            for (int rt = 0; rt < 4; ++rt) if (g + rt < NRT) acc[g + rt] = MFMA32(wf, bt[rt], acc[g + rt]);
        }
        __builtin_amdgcn_sched_barrier(0);
        wf = wfn;
    }
#pragma unroll
    for (int i = 0; i < 4; ++i) *(LAS bf16x8*)(lds + L4_ABUF + bnxt * (256 * EAP) + swr + i * 8 * EAP) = swr_regs[i];
    __syncthreads();
}
template <int NRT>
DI void p4_run(f32x16 (&acc)[NRT], P4St& S, const float* wb, int loff, const bf16* h2g, const int (&roff)[4], LAS char* lds, int wv, int lane, int l31, int h) {
#pragma unroll
    for (int rt = 0; rt < NRT; ++rt)
#pragma unroll
        for (int r = 0; r < 16; ++r) acc[rt][r] = 0.f;
    const int swr = (32 * wv + (lane >> 3)) * EAP + 16 * (lane & 7);
    LAS char* wsc = lds + L4_WSC + wv * WSC_BYTES;
#pragma unroll
    for (int i = 0; i < 4; ++i) *(LAS bf16x8*)(lds + L4_ABUF + swr + i * 8 * EAP) = S.sa[i];
    bf16x8 wf = wfrag_from(S.raw[0], wsc, lane);
    load_wraw(S.raw[0], wb + (size_t)4 * 16 * ED, ED, loff);
    __syncthreads();
#pragma unroll 1
    for (int kc = 0; kc < 16; kc += 2) {
        p4_chunk<NRT>(acc, S, wf, S.sa, S.sb, kc, wb, loff, h2g, roff, lds, wsc, swr, lane, l31, h);
        p4_chunk<NRT>(acc, S, wf, S.sb, S.sa, kc + 1, wb, loff, h2g, roff, lds, wsc, swr, lane, l31, h);
    }
}
template <int NRT>
DI void p4_item(const Params& p, LAS char* lds, const float* wg0, const float* wu0, const float* wd0, int nrows, int wv, int vcu) {
    LAS int* rowasg = (LAS int*)(lds + L4_ROW);
    LAS float* rowgate = (LAS float*)(lds + L4_GATE);
    const int lane = lane_opaque(), h = lane >> 5, l31 = lane & 31;
    bf16x8* dump = (bf16x8*)(p.ws + WS_SG) + (size_t)(vcu * NWAVE + wv) * 16 * 64 + lane;
    const bf16* h2g = (const bf16*)(p.ws + WS_H2);
    int roff[4];
#pragma unroll
    for (int i = 0; i < 4; ++i) roff[i] = (rowasg[32 * wv + 8 * i + (lane >> 3)] >> 3) * DM + 8 * (lane & 7);
    bf16* ybuf = (bf16*)(p.ws + WS_Y);
    f32x16 acc[NRT];
    const int loff1 = (lane >> 3) * ED + 4 * (lane & 7);
    const float* wgb = wg0 + 32 * wv;
    const float* wub = wu0 + 32 * wv;
    P4St S;
    p4_issue(S, wgb, loff1, h2g, roff);
    p4_run<NRT>(acc, S, wgb, loff1, h2g, roff, lds, wv, lane, l31, h);
    p4_issue(S, wub, loff1, h2g, roff);
#pragma unroll
    for (int rt = 0; rt < NRT; ++rt) {
        bf16x8 d0, d1;
#pragma unroll
        for (int j = 0; j < 8; ++j) { d0[j] = (bf16)silu_f(acc[rt][j]); d1[j] = (bf16)silu_f(acc[rt][8 + j]); }
        dump[(2 * rt) * 64] = d0; dump[(2 * rt + 1) * 64] = d1;
        __builtin_amdgcn_sched_barrier(0);
    }
    p4_run<NRT>(acc, S, wub, loff1, h2g, roff, lds, wv, lane, l31, h);
    const int loff2 = (lane_opaque() >> 3) * DM + 4 * (lane_opaque() & 7);
    const float* wdb = wd0 + 32 * wv;
    WRaw raw[4];
#pragma unroll
    for (int q = 0; q < 4; ++q) load_wraw(raw[q], wdb + (size_t)q * 16 * DM, DM, loff2);
    const bf16x8* dump2 = (const bf16x8*)(p.ws + WS_SG) + (size_t)(vcu * NWAVE + wv) * 16 * 64 + lane_opaque();
#pragma unroll
    for (int rt = 0; rt < NRT; ++rt) {
        const bf16x8 d0 = __builtin_nontemporal_load(&dump2[(2 * rt) * 64]), d1 = __builtin_nontemporal_load(&dump2[(2 * rt + 1) * 64]);
        const float gq = rowgate[32 * rt + l31];
        LAS char* dst = lds + L4_ACT + (32 * rt + l31) * ACTP + (32 * wv + 4 * h) * 2;
#pragma unroll
        for (int g4 = 0; g4 < 4; ++g4) {
            float a[4];
#pragma unroll
            for (int e2 = 0; e2 < 4; ++e2) { const int r = 4 * g4 + e2; a[e2] = (float)(r < 8 ? d0[r] : d1[r - 8]) * acc[rt][r] * gq; }
            *(LAS bf16x4*)(dst + 16 * g4) = pack4(a[0], a[1], a[2], a[3]);
        }
    }
    __syncthreads();
    {
        LAS char* wsc = lds + L4_WSC + wv * WSC_BYTES;
        const LAS char* ab = lds + L4_ACT + l31 * ACTP + 16 * h;
        bf16x8 wf = wfrag_from(raw[0], wsc, lane);
        load_wraw(raw[0], wdb + (size_t)4 * 16 * DM, DM, loff2);
        bf16x8 bt[NRT];
#pragma unroll
        for (int rt = 0; rt < NRT; ++rt) bt[rt] = *(const LAS bf16x8*)(ab + rt * 32 * ACTP);
#pragma unroll 1
        for (int np = 0; np < 4; ++np) {
#pragma unroll
            for (int rt = 0; rt < NRT; ++rt)
#pragma unroll
                for (int r = 0; r < 16; ++r) acc[rt][r] = 0.f;
#pragma unroll 1
            for (int k4 = 0; k4 < 16; k4 += 4) {
#pragma unroll
                for (int q = 0; q < 4; ++q) {
                    const int ks = k4 + q, gn = (16 * np + ks + 5) & 63;
                    const bf16x8 wfn = wfrag_from(raw[(q + 1) & 3], wsc, lane);
                    load_wraw(raw[(q + 1) & 3], wdb + (size_t)(gn & 15) * 16 * DM + 256 * (gn >> 4), DM, loff2);
                    bf16x8 btn[NRT];
#pragma unroll
                    for (int rt = 0; rt < NRT; ++rt) btn[rt] = *(const LAS bf16x8*)(ab + rt * 32 * ACTP + 32 * ((ks + 1) & 15));
                    __builtin_amdgcn_sched_barrier(0);
#pragma unroll
                    for (int rt = 0; rt < NRT; ++rt) acc[rt] = MFMA32(wf, bt[rt], acc[rt]);
                    __builtin_amdgcn_sched_barrier(0);
                    wf = wfn;
#pragma unroll
                    for (int rt = 0; rt < NRT; ++rt) bt[rt] = btn[rt];
                }
            }
            const int n0 = 256 * np + 32 * wv;
            {
                int lo2 = lane; asm volatile("" : "+v"(lo2));
                const int trow = lo2 >> 2, tpc = lo2 & 3;
                LAS char* wt = wsc + (lo2 & 31) * 80 + 8 * (lo2 >> 5);
                const LAS char* rd = wsc + trow * 80 + tpc * 16;
                const LAS char* yo = lds + L4_YOFF + 4 * trow;
                const unsigned colb = (unsigned)(n0 + 8 * tpc) * 2u;
#pragma unroll
                for (int rt = 0; rt < NRT; ++rt) {
#pragma unroll
                    for (int g4 = 0; g4 < 4; ++g4)
                        *(LAS bf16x4*)(wt + 16 * g4) = pack4(acc[rt][4 * g4], acc[rt][4 * g4 + 1], acc[rt][4 * g4 + 2], acc[rt][4 * g4 + 3]);
#pragma unroll
                    for (int j2 = 0; j2 < 2; ++j2) {
                        const bf16x8 v = *(const LAS bf16x8*)(rd + j2 * 16 * 80);
                        const unsigned off = (unsigned)*(const LAS int*)(yo + 4 * (32 * rt + 16 * j2)) + colb;
                        *(bf16x8*)((char*)ybuf + off) = v;
                    }
                    __builtin_amdgcn_sched_barrier(0);
                }
            }
        }
    }
    __syncthreads();
}
constexpr int L4_PFX8 = L4_PFX;
static_assert(8 * 33 * 4 <= 1040 + 0 || true, "");
DI void phase4(const Params& p, LAS char* lds, int vcu, int G, int wid, unsigned* qctr) {
    const int wv = wid_opaque(wid);
    const unsigned* cnt = (const unsigned*)(p.ws + WS_CTL + CTL_CNT);
    LAS int* nchs = (LAS int*)(lds + L4_NCH);
    LAS int* pfx8 = (LAS int*)(lds + L4_WSC);
    pfx8 = (LAS int*)(lds + L4_WSC + 8 * WSC_BYTES);
    LAS int* rowasg = (LAS int*)(lds + L4_ROW);
    LAS float* rowgate = (LAS float*)(lds + L4_GATE);
    volatile LAS int* itemw = (volatile LAS int*)(lds + L4_ITEM);
    LAS int* ord8 = (LAS int*)(lds + L4_PFX);
    {
        const int tid = wv * 64 + lane_opaque();
        LAS int* rpcs = (LAS int*)(lds + L4_WSC);
        if (tid < NE) { const int ne = (int)cnt[tid], nch = (ne + 255) >> 8; nchs[tid] = nch; rpcs[tid] = nch ? ((((ne + nch - 1) / nch) + 31) & ~31) : 0; }
        __syncthreads();
        if (tid < NE) {
            const int x = tid & 7, j = tid >> 3, mine = rpcs[tid];
            int rank = 0;
            for (int j2 = 0; j2 < 32; ++j2) { const int o = rpcs[8 * j2 + x]; rank += (o > mine || (o == mine && j2 < j)) ? 1 : 0; }
            ord8[x * 32 + rank] = j;
        }
        __syncthreads();
        if (tid < 8 * 33) { const int x = tid / 33, r = tid % 33; int s = 0; for (int i = 0; i < r; ++i) s += nchs[8 * ord8[x * 32 + i] + x]; pfx8[tid] = s; }
        __syncthreads();
    }
    const int* list = (const int*)(p.ws + WS_LIST);
    const float* gatebuf = (const float*)(p.ws + WS_GATE);
    const int myx = (int)(xb_xcc_id() & 7u);
#pragma unroll 1
    for (int sx = 0; sx < 8; ++sx) {
        const int x = (myx + sx) & 7;
        const int total = __builtin_amdgcn_readfirstlane(pfx8[x * 33 + 32]);
        for (;;) {
            if (wv == 0 && lane_opaque() == 0) itemw[0] = (int)atomicAdd(qctr + 64 * x, 1u);
            __syncthreads();
            const int it = __builtin_amdgcn_readfirstlane(itemw[0]);
            if (it >= total + 8) break;
            const float *wg0, *wu0, *wd0; int nrows;
            if (it < total) {
                int lo = 0, hi = 31;
                while (lo < hi) { const int mid = (lo + hi + 1) >> 1; if (pfx8[x * 33 + mid] <= it) lo = mid; else hi = mid - 1; }
                const int rk = __builtin_amdgcn_readfirstlane(lo), j = __builtin_amdgcn_readfirstlane(ord8[x * 32 + rk]), e = 8 * j + x, ch = it - __builtin_amdgcn_readfirstlane(pfx8[x * 33 + rk]);
                const int ne = __builtin_amdgcn_readfirstlane((int)cnt[e]), nch = __builtin_amdgcn_readfirstlane(nchs[e]);
                const int rpc = (((ne + nch - 1) / nch) + 31) & ~31, r0 = ch * rpc;
                nrows = min(rpc, ne - r0);
                wg0 = p.w_gate_e + (size_t)e * DM * ED; wu0 = p.w_up_e + (size_t)e * DM * ED; wd0 = p.w_down_e + (size_t)e * ED * DM;
                const int tid = wv * 64 + lane_opaque();
                if (tid < 256) { const int a = list[(size_t)e * LCAP + r0 + min(tid, nrows - 1)]; rowasg[tid] = a; rowgate[tid] = gatebuf[a]; ((LAS int*)(lds + L4_YOFF))[tid] = (tid < nrows ? a : NTOK * 8) * (DM * 2); }
            } else {
                const int tb = 8 * x + (it - total);
                nrows = 256;
                wg0 = p.w_gate_s; wu0 = p.w_up_s; wd0 = p.w_down_s;
                const int tid = wv * 64 + lane_opaque();
                if (tid < 256) { const int tok = 256 * tb + tid; rowasg[tid] = tok * 8; rowgate[tid] = 1.f; ((LAS int*)(lds + L4_YOFF))[tid] = (YSH0 + tok) * (DM * 2); }
            }
            const int nrt = (nrows + 31) >> 5;
            __syncthreads();
            if (nrt <= 4) p4_item<4>(p, lds, wg0, wu0, wd0, nrows, wv, vcu);
            else if (nrt <= 6) p4_item<6>(p, lds, wg0, wu0, wd0, nrows, wv, vcu);
            else p4_item<8>(p, lds, wg0, wu0, wd0, nrows, wv, vcu);
        }
        __syncthreads();
    }
}

DI void phase5(const Params& p, int vcu, int G, int wid) {
    const bf16* ybuf = (const bf16*)(p.ws + WS_Y);
    const int gtid = vcu * NTHR + tid_of(wid), gth = G * NTHR;
    for (int i = gtid; i < NTOK * (DM / 8); i += gth) {
        const int tok = i >> 7, n = (i & 127) * 8, b = tok / SEQ;
        float s[8];
#pragma unroll
        for (int e = 0; e < 8; ++e) s[e] = 0.f;
#pragma unroll
        for (int k = 0; k < 9; ++k) {
            const bf16x8 v = *(const bf16x8*)(ybuf + (k < 8 ? (size_t)tok * 8 + k : (size_t)YSH0 + tok) * DM + n);
#pragma unroll
            for (int e = 0; e < 8; ++e) s[e] += (float)v[e];
        }
        float* op = p.out + (size_t)tok * DM + n;
        f32x4 o0 = *(f32x4*)op, o1 = *(f32x4*)(op + 4);
        const float* gm = (const float*)(p.ws + WS_MODF) + b * 6144 + 5 * DM + n;
        const f32x4 g0 = *(const f32x4*)gm, g1 = *(const f32x4*)(gm + 4);
#pragma unroll
        for (int e = 0; e < 4; ++e) { o0[e] += g0[e] * s[e]; o1[e] += g1[e] * s[4 + e]; }
        *(f32x4*)op = o0; *(f32x4*)(op + 4) = o1;
    }
}

DI int vcu_of(int bx, int G) { return (G % 8 == 0) ? (bx % 8) * (G / 8) + bx / 8 : bx; }
#if FUSED
__global__ void __launch_bounds__(NTHR) mk_fwd(Params p) {
    extern __shared__ __attribute__((aligned(16))) unsigned char lds_raw[];
    LAS char* lds = (LAS char*)lds_raw;
    const int G = gridDim.x, vcu = vcu_of(blockIdx.x, G);
    const int wid = __builtin_amdgcn_readfirstlane((int)threadIdx.x >> 6);
    volatile LAS unsigned* st = (volatile LAS unsigned*)(lds + LDS_BARW);
    if (tid_of(wid) == 0) { st[0] = 0u; st[1] = 0u; }
    __syncthreads();
    XcdBarrier bar = xcd_barrier_post((unsigned*)(p.ws + WS_CTL), st, wid);
    phase0(p, lds, vcu, G, wid);
    xcd_barrier(bar);
    if (REP == 0) { phase0(p, lds, vcu, G, wid); xcd_barrier(bar); }
    phase1(p, lds, vcu, wid);
    xcd_barrier(bar);
    if (REP == 1) { phase1(p, lds, vcu, wid); xcd_barrier(bar); }
    phase2(p, lds, vcu, G, wid);
    xcd_barrier(bar);
    if (REP == 2) { phase2(p, lds, vcu, G, wid); xcd_barrier(bar); }
    phase3(p, lds, vcu, wid);
    xcd_barrier(bar);
    phase4(p, lds, vcu, G, wid, (unsigned*)(p.ws + WS_CTL + CTL_Q));
    xcd_barrier(bar);
    if (REP == 4) { phase4(p, lds, vcu, G, wid, (unsigned*)(p.ws + WS_CTL + CTL_Q + 2048)); xcd_barrier(bar); }
    phase5(p, vcu, G, wid);
}
#else
#define LDSDECL extern __shared__ __attribute__((aligned(16))) unsigned char lds_raw[]; LAS char* lds = (LAS char*)lds_raw; const int G = gridDim.x, vcu = vcu_of(blockIdx.x, G); const int wid = __builtin_amdgcn_readfirstlane((int)threadIdx.x >> 6); (void)lds; (void)vcu;
__global__ void __launch_bounds__(NTHR) k_p0(Params p) { LDSDECL phase0(p, lds, vcu, G, wid); }
__global__ void __launch_bounds__(NTHR) k_p1(Params p) { LDSDECL phase1(p, lds, vcu, wid); }
__global__ void __launch_bounds__(NTHR) k_p2(Params p) { LDSDECL phase2(p, lds, vcu, G, wid); }
__global__ void __launch_bounds__(NTHR) k_p3(Params p) { LDSDECL phase3(p, lds, vcu, wid); }
__global__ void __launch_bounds__(NTHR) k_p4(Params p) { LDSDECL phase4(p, lds, vcu, G, wid, (unsigned*)(p.ws + WS_CTL + CTL_Q)); }
__global__ void __launch_bounds__(NTHR) k_p5(Params p) { LDSDECL phase5(p, vcu, G, wid); }
#endif

extern "C" void kernel_launch(void* const* d_in, const int* in_sizes, int n_in, void* d_out, int out_size, void* d_ws, size_t ws_size, hipStream_t stream) {
    if (n_in != 24 || ws_size < WS_END) { fprintf(stderr, "kernel_launch: unexpected inputs (n_in %d, ws %zu < %zu)\n", n_in, ws_size, (size_t)WS_END); return; }
    Params p{};
    p.x = (const float*)d_in[0]; p.c = (const float*)d_in[1]; p.pos = (const int*)d_in[2];
    p.w_ada = (const float*)d_in[3]; p.b_ada = (const float*)d_in[4]; p.g_mix = (const float*)d_in[5]; p.w_in = (const float*)d_in[6];
    p.g_q_a = (const float*)d_in[7]; p.g_k_a = (const float*)d_in[8]; p.sinks = (const float*)d_in[9]; p.g_q_b = (const float*)d_in[10]; p.g_k_b = (const float*)d_in[11];
    p.g_out_a = (const float*)d_in[12]; p.g_out_b = (const float*)d_in[13]; p.w_out = (const float*)d_in[14]; p.g_ffn = (const float*)d_in[15];
    p.w_router = (const float*)d_in[16]; p.r_bias = (const float*)d_in[17]; p.w_gate_e = (const float*)d_in[18]; p.w_up_e = (const float*)d_in[19]; p.w_down_e = (const float*)d_in[20];
    p.w_gate_s = (const float*)d_in[21]; p.w_up_s = (const float*)d_in[22]; p.w_down_s = (const float*)d_in[23];
    p.out = (float*)d_out; p.ws = (unsigned char*)d_ws;
    hipMemsetAsync((char*)d_ws + WS_CTL, 0, CTL_BYTES, stream);
    const int G = 256;
#if FUSED
    static bool attr_done = false;
    if (!attr_done) { hipFuncSetAttribute((const void*)mk_fwd, hipFuncAttributeMaxDynamicSharedMemorySize, LDS_BYTES); attr_done = true; }
    void* args[] = { &p };
    hipError_t e = hipLaunchCooperativeKernel((const void*)mk_fwd, dim3(G), dim3(NTHR), args, LDS_BYTES, stream);
    if (e != hipSuccess) fprintf(stderr, "cooperative launch failed: %s\n", hipGetErrorString(e));
#else
    static bool attr_done = false;
    if (!attr_done) {
        hipFuncSetAttribute((const void*)k_p0, hipFuncAttributeMaxDynamicSharedMemorySize, LDS_BYTES);
        hipFuncSetAttribute((const void*)k_p1, hipFuncAttributeMaxDynamicSharedMemorySize, LDS_BYTES);
        hipFuncSetAttribute((const void*)k_p2, hipFuncAttributeMaxDynamicSharedMemorySize, LDS_BYTES);
        hipFuncSetAttribute((const void*)k_p3, hipFuncAttributeMaxDynamicSharedMemorySize, LDS_BYTES);
        hipFuncSetAttribute((const void*)k_p4, hipFuncAttributeMaxDynamicSharedMemorySize, LDS_BYTES);
        hipFuncSetAttribute((const void*)k_p5, hipFuncAttributeMaxDynamicSharedMemorySize, LDS_BYTES);
        attr_done = true;
    }
    hipLaunchKernelGGL(k_p0, dim3(G), dim3(NTHR), LDS_BYTES, stream, p);
    hipLaunchKernelGGL(k_p1, dim3(G), dim3(NTHR), LDS_BYTES, stream, p);
    hipLaunchKernelGGL(k_p2, dim3(G), dim3(NTHR), LDS_BYTES, stream, p);
    hipLaunchKernelGGL(k_p3, dim3(G), dim3(NTHR), LDS_BYTES, stream, p);
    hipLaunchKernelGGL(k_p4, dim3(G), dim3(NTHR), LDS_BYTES, stream, p);
    hipLaunchKernelGGL(k_p5, dim3(G), dim3(NTHR), LDS_BYTES, stream, p);
#endif
}
```
